# Optimizing an MI355X kernel written in HIP

```python
import jax, jax.numpy as jnp
from jax import lax
import numpy as np

D_MODEL = 1024
BATCH = 16
SEQ = 4096
DEPTH = 4

CHUNK = 64
RWKV_HEADS = 8
RWKV_HEAD_DIM = 64
RWKV_WIDTH = RWKV_HEADS * RWKV_HEAD_DIM
DECAY_LORA = 64
AAA_LORA = 64
VRES_LORA = 32
GATE_LORA = 128
GMLP_BLOCK = 128
GMLP_GROUPS = 4
GMLP_WIDTH = 512
GMLP_GROUP_DIM = GMLP_WIDTH // GMLP_GROUPS
D_FF = 4 * D_MODEL
N_MOD = 6
RMS_EPS = 1e-6
LN_EPS = 1e-5
GN_EPS = 64e-5

RWKV_COLS = 3 * RWKV_WIDTH + DECAY_LORA + AAA_LORA + GATE_LORA
GMLP_COLS = 2 * GMLP_WIDTH
GATE_COLS = 2 * D_MODEL
IN_COLS = RWKV_COLS + GMLP_COLS + GATE_COLS
RWKV_SPLITS = (RWKV_WIDTH, 2 * RWKV_WIDTH, 3 * RWKV_WIDTH,
               3 * RWKV_WIDTH + DECAY_LORA, 3 * RWKV_WIDTH + DECAY_LORA + AAA_LORA)

kernel_name = 'hybrid_rwkv7_gmlp_adaln_trunk'


def rms_norm(x, gain):
    xf = x.astype(jnp.float32)
    ms = jnp.mean(xf * xf, axis=-1, keepdims=True)
    return (xf * lax.rsqrt(ms + RMS_EPS)).astype(x.dtype) * gain


def modulate(h, shift, scale):
    return h * (1.0 + scale[:, None, :]) + shift[:, None, :]


def token_shift(p):
    return jnp.pad(p[:, :-1], ((0, 0), (1, 0), (0, 0)))


def wkv7_scan(r, decay, k, v, a, b):
    def step(state, inp):
        r_t, w_t, k_t, v_t, a_t, b_t = inp
        sa = jnp.einsum('bhij,bhj->bhi', state, a_t)
        state = (state * w_t[:, :, None, :] + sa[..., None] * b_t[:, :, None, :]
                 + v_t[..., None] * k_t[:, :, None, :])
        return state, jnp.einsum('bhij,bhj->bhi', state, r_t)
    xs = tuple(jnp.moveaxis(t.astype(jnp.float32), 1, 0) for t in (r, decay, k, v, a, b))
    B, S, H, N = r.shape
    s0 = jnp.zeros((B, H, N, N), jnp.float32)
    _, ys = lax.scan(step, s0, xs)
    return jnp.moveaxis(ys, 0, 1)


def rwkv7_mix(p_rw, mu, w0, w2_w, a0, w2_a, w2_g, k_k, k_a, r_k, gn_w, gn_b, v_first, vres):
    B, S, _ = p_rw.shape
    H, N = RWKV_HEADS, RWKV_HEAD_DIM
    xs = p_rw + (token_shift(p_rw) - p_rw) * mu
    r, k, v, w_lo, a_lo, g_lo = jnp.split(xs, RWKV_SPLITS, axis=-1)
    w_log = -jax.nn.softplus(-(w0 + jnp.tanh(w_lo) @ w2_w)) - 0.5
    decay = jnp.exp(-jnp.exp(w_log.astype(jnp.float32)))
    a = jax.nn.sigmoid(a0 + a_lo @ w2_a)
    g = jax.nn.sigmoid(g_lo) @ w2_g
    if vres is not None:
        v0, v1, v2 = vres
        v = v + (v_first - v) * jax.nn.sigmoid(v0 + (v @ v1) @ v2)
    kk = (k * k_k).reshape(B, S, H, N).astype(jnp.float32)
    kk = kk / jnp.maximum(jnp.sqrt(jnp.sum(kk * kk, axis=-1, keepdims=True)), 1e-12)
    k = k * (1.0 + (a - 1.0) * k_a)
    rh = r.reshape(B, S, H, N)
    kh = k.reshape(B, S, H, N)
    vh = v.reshape(B, S, H, N)
    ah = a.reshape(B, S, H, N)
    y = wkv7_scan(rh, decay.reshape(B, S, H, N), kh, vh, -kk, kk * ah)
    mean = jnp.mean(y, axis=-1, keepdims=True)
    var = jnp.mean(jnp.square(y - mean), axis=-1, keepdims=True)
    y = ((y - mean) * lax.rsqrt(var + GN_EPS)).reshape(B, S, RWKV_WIDTH) * gn_w + gn_b
    bonus = (jnp.sum(rh * kh * r_k, axis=-1, keepdims=True) * vh).reshape(B, S, RWKV_WIDTH)
    return (y + bonus) * g, v


def gmlp_mix(p_gm, ln_w, ln_b, w_s, b_s, mask):
    z = jax.nn.gelu(p_gm, approximate=False)
    u, v = jnp.split(z, 2, axis=-1)
    vf = v.astype(jnp.float32)
    mean = jnp.mean(vf, axis=-1, keepdims=True)
    var = jnp.mean(jnp.square(vf - mean), axis=-1, keepdims=True)
    v = ((vf - mean) * lax.rsqrt(var + LN_EPS)).astype(v.dtype) * ln_w + ln_b
    B, S, _ = v.shape
    vb = v.reshape(B, S // GMLP_BLOCK, GMLP_BLOCK, GMLP_GROUPS, GMLP_GROUP_DIM)
    ws = w_s * mask
    sv = jnp.einsum('gij,bnjgd->bnigd', ws, vb) + b_s.T[None, None, :, :, None]
    return u * sv.reshape(B, S, GMLP_WIDTH)


def setup_inputs(seed: int = 0) -> dict:
    key = jax.random.key(seed)
    ks = iter(jax.random.split(key, 40))
    nrm = lambda shape, s: jax.random.normal(next(ks), shape, jnp.float32) * s
    uni = lambda shape, lo, hi: jax.random.uniform(next(ks), shape, jnp.float32, lo, hi)
    L, D, RW, GW, T, G = DEPTH, D_MODEL, RWKV_WIDTH, GMLP_WIDTH, GMLP_BLOCK, GMLP_GROUPS
    return {
        'x': nrm((BATCH, SEQ, D), 1.0),
        'c': nrm((BATCH, D), 1.0),
        'w_ada': nrm((L, D, N_MOD * D), 0.2 * D ** -0.5),
        'b_ada': nrm((L, N_MOD * D), 0.02),
        'norm1_g': 1.0 + nrm((L, D), 0.05),
        'norm2_g': 1.0 + nrm((L, D), 0.05),
        'w_in': nrm((L, D, IN_COLS), D ** -0.5),
        'mu_shift': uni((L, RWKV_COLS), 0.0, 1.0),
        'w0_decay': uni((L, RW), -6.0, -1.0),
        'w2_decay': nrm((L, DECAY_LORA, RW), 0.1),
        'a0': nrm((L, RW), 0.1),
        'w2_aaa': nrm((L, AAA_LORA, RW), AAA_LORA ** -0.5),
        'w2_gate': nrm((L, GATE_LORA, RW), GATE_LORA ** -0.5),
        'k_k': 0.85 + nrm((L, RW), 0.05),
        'k_a': 1.0 + nrm((L, RW), 0.05),
        'r_k': nrm((L, RWKV_HEADS, RWKV_HEAD_DIM), 0.1),
        'gn_w': 1.0 + nrm((L, RW), 0.05),
        'gn_b': nrm((L, RW), 0.02),
        'v0_res': nrm((L - 1, RW), 0.1),
        'w1_res': nrm((L - 1, RW, VRES_LORA), RW ** -0.5),
        'w2_res': nrm((L - 1, VRES_LORA, RW), VRES_LORA ** -0.5),
        'ln_gmlp_w': 1.0 + nrm((L, GW), 0.05),
        'ln_gmlp_b': nrm((L, GW), 0.02),
        'w_spatial': nrm((L, G, T, T), 0.5 * T ** -0.5),
        'b_spatial': 1.0 + nrm((L, G, T), 0.1),
        'w_br_rwkv': nrm((L, RW, D), RW ** -0.5),
        'w_br_gmlp': nrm((L, GW, D), GW ** -0.5),
        'w_out': nrm((L, D, D), D ** -0.5),
        'w_ff1': nrm((L, D, D_FF), D ** -0.5),
        'w_ff2': nrm((L, D_FF, D), D_FF ** -0.5),
        'final_g': 1.0 + nrm((D,), 0.05),
    }


def reference(x, c, w_ada, b_ada, norm1_g, norm2_g, w_in, mu_shift, w0_decay, w2_decay, a0,
              w2_aaa, w2_gate, k_k, k_a, r_k, gn_w, gn_b, v0_res, w1_res, w2_res,
              ln_gmlp_w, ln_gmlp_b, w_spatial, b_spatial, w_br_rwkv, w_br_gmlp, w_out,
              w_ff1, w_ff2, final_g):
    pos = jnp.arange(GMLP_BLOCK)
    mask = (pos[:, None] // CHUNK >= pos[None, :] // CHUNK).astype(w_spatial.dtype)
    c_act = jax.nn.silu(c)
    v_first = None
    for l in range(DEPTH):
        mod = c_act @ w_ada[l] + b_ada[l]
        sh1, sc1, gt1, sh2, sc2, gt2 = jnp.split(mod, N_MOD, axis=-1)
        h = modulate(rms_norm(x, norm1_g[l]), sh1, sc1)
        p = h @ w_in[l]
        p_rw, p_gm, p_ga, p_gb = jnp.split(
            p, [RWKV_COLS, RWKV_COLS + GMLP_COLS, RWKV_COLS + GMLP_COLS + D_MODEL], axis=-1)
        vres = None if l == 0 else (v0_res[l - 1], w1_res[l - 1], w2_res[l - 1])
        y_rw, v_l = rwkv7_mix(p_rw, mu_shift[l], w0_decay[l], w2_decay[l], a0[l], w2_aaa[l],
                              w2_gate[l], k_k[l], k_a[l], r_k[l], gn_w[l], gn_b[l], v_first, vres)
        if l == 0:
            v_first = v_l
        y_gm = gmlp_mix(p_gm, ln_gmlp_w[l], ln_gmlp_b[l], w_spatial[l], b_spatial[l], mask)
        merged = (jax.nn.sigmoid(p_ga) * (y_rw @ w_br_rwkv[l])
                  + jax.nn.sigmoid(p_gb) * (y_gm @ w_br_gmlp[l]))
        x = x + gt1[:, None, :] * (merged @ w_out[l])
        h2 = modulate(rms_norm(x, norm2_g[l]), sh2, sc2)
        ff = jnp.square(jax.nn.relu(h2 @ w_ff1[l])) @ w_ff2[l]
        x = x + gt2[:, None, :] * ff
    return rms_norm(x, final_g)
```

```cpp
#include <hip/hip_runtime.h>
#include <hip/hip_cooperative_groups.h>
#include <cstdio>
#include <cstdint>
namespace cg = cooperative_groups;

#define LAS __attribute__((address_space(3)))
typedef unsigned short bf16_t;
typedef short bf16x8 __attribute__((ext_vector_type(8)));
typedef float f32x4 __attribute__((ext_vector_type(4)));
typedef float f32x2 __attribute__((ext_vector_type(2)));
typedef unsigned u32x4 __attribute__((ext_vector_type(4)));
typedef unsigned u32x2 __attribute__((ext_vector_type(2)));

constexpr int NB = 16, SEQ = 4096, DM = 1024, M = NB * SEQ, NL = 4;
constexpr int RW = 512, INC = 4864, RWC = 1792, DFF = 4096, NMOD = 6 * DM;
constexpr size_t U = 64ull << 20;
constexpr size_t O_IN = 0, O_LORA = O_IN + 4864ull * 1024, O_V12 = O_LORA + 1536ull * 256, O_WS = O_V12 + 512ull * 512,
                 O_BR1 = O_WS + 4ull * 128 * 128, O_BR2 = O_BR1 + 1024ull * 512, O_OUT = O_BR2 + 1024ull * 512,
                 O_FF1 = O_OUT + 1024ull * 1024, O_FF2 = O_FF1 + 4096ull * 1024, LW = O_FF2 + 1024ull * 4096;
constexpr size_t WS_BAR = (125ull << 20) + (512ull << 10), WS_BAR_BYTES = 16384;
constexpr size_t WS_MOD = 124ull << 20, WS_CB = 126ull << 20;
static_assert(LW * 2 * NL <= WS_MOD, "weights fit");
constexpr size_t WS_VF = 2 * U, WS_G = 3 * U, WS_PGM = 7 * U, WS_PRW = 9 * U, WS_LIN = 12 * U + U / 2, WS_R = 13 * U, WS_K0 = 14 * U,
                 WS_V0 = 15 * U, WS_YRW = 15 * U, WS_OMD = 9 * U, WS_ASIG = 10 * U, WS_GT = 11 * U, WS_MGF = 9 * U, WS_MG = 13 * U,
                 WS_H = 13 * U, WS_FH = 3 * U, WS_END = 16 * U;
static_assert(WS_ASIG == WS_OMD + U && WS_GT == WS_OMD + 2 * U, "EpiLora output spacing");
constexpr int LDS_BYTES = 135168;

#define GAS __attribute__((address_space(1)))
typedef const float GAS* gcf_t;
struct Params {
    gcf_t x, c, w_ada, b_ada, norm1_g, norm2_g, w_in, mu_shift, w0_decay, w2_decay, a0, w2_aaa, w2_gate, k_k, k_a, r_k,
        gn_w, gn_b, v0_res, w1_res, w2_res, ln_w, ln_b, w_sp, b_sp, w_br_rw, w_br_gm, w_out, w_ff1, w_ff2, final_g;
    float GAS* out; unsigned char GAS* ws;
};

#define GP(ptr_) ((const float*)(ptr_))
__device__ __forceinline__ float bflo(unsigned w) { return __builtin_bit_cast(float, w << 16); }
__device__ __forceinline__ float bfhi(unsigned w) { return __builtin_bit_cast(float, w & 0xffff0000u); }
__device__ __forceinline__ float bf1(bf16_t v) { return __builtin_bit_cast(float, (unsigned)v << 16); }
__device__ __forceinline__ unsigned f2bf(float f) { unsigned u = __builtin_bit_cast(unsigned, f); return (u + 0x7fffu + ((u >> 16) & 1u)) >> 16; }
typedef __bf16 bf16x2_t __attribute__((ext_vector_type(2)));
__device__ __forceinline__ unsigned pk2(float lo, float hi) { const f32x2 v = {lo, hi}; const bf16x2_t b = __builtin_convertvector(v, bf16x2_t); return __builtin_bit_cast(unsigned, b); }
__device__ __forceinline__ float rcpf_(float x) { return __builtin_amdgcn_rcpf(x); }
__device__ __forceinline__ float sigmoidf_(float x) { return rcpf_(1.f + __expf(-x)); }
__device__ __forceinline__ float tanhf_(float x) { return 1.f - 2.f * rcpf_(__expf(2.f * x) + 1.f); }
#define DPP_ADD(x, ctrl) ((x) + __builtin_bit_cast(float, __builtin_amdgcn_update_dpp(0, __builtin_bit_cast(int, (x)), (ctrl), 0xF, 0xF, true)))
__device__ __forceinline__ float red8(float x) { x = DPP_ADD(x, 0xB1); x = DPP_ADD(x, 0x4E); x = DPP_ADD(x, 0x141); return x; }
__device__ __forceinline__ float row_sum16(float x) { x = red8(x); x = DPP_ADD(x, 0x140); return x; }
__device__ __forceinline__ float half_sum(float v) {
    v = row_sum16(v);
    return v + __builtin_bit_cast(float, __builtin_amdgcn_ds_swizzle(__builtin_bit_cast(int, v), 0x401F));
}
__device__ __forceinline__ float wave_sum(float v) {
    v = half_sum(v);
    return __builtin_bit_cast(float, __builtin_amdgcn_readlane(__builtin_bit_cast(int, v), 0)) + __builtin_bit_cast(float, __builtin_amdgcn_readlane(__builtin_bit_cast(int, v), 32));
}
__device__ __forceinline__ int opaque_tid() { int t = threadIdx.x; asm volatile("" : "+v"(t)); return t; }
__device__ __forceinline__ const struct Params* opaque_params() { const struct Params* q = (const struct Params*)__builtin_amdgcn_kernarg_segment_ptr(); asm volatile("" : "+s"(q)); return q; }
__device__ __forceinline__ int opaque_bid() { int b = blockIdx.x; asm volatile("" : "+s"(b)); return b; }
__device__ __forceinline__ float omd_of(float d) {
    const float x = -d, sp = fmaxf(x, 0.f) + 0.69314718f * __builtin_amdgcn_logf(1.f + __builtin_amdgcn_exp2f(-1.44269504f * fabsf(x)));
    const float e = __builtin_amdgcn_exp2f((-sp - 0.5f) * 1.44269504f);
    const float poly = e * (1.f - e * (0.5f - e * (0.16666667f - e * (0.041666668f - e * 0.0083333333f))));
    const float big = 1.f - __builtin_amdgcn_exp2f(-1.44269504f * e);
    return e < 0.125f ? poly : big;
}
__device__ __forceinline__ float decay_of(float d) {
    const float sg = rcpf_(1.f + __builtin_amdgcn_exp2f(-1.44269504f * d));
    return __builtin_amdgcn_exp2f(-0.87503877f * sg);
}
__device__ __forceinline__ float gelu1(float v) {
    const float av = fabsf(v), t = rcpf_(av * 0.2316418882f + 1.0f);
    float q = t * 0.5307027145f + (-0.7265760135f); q = q * t + 0.7107068705f; q = q * t + (-0.142248368f); q = q * t + 0.127414796f; q = q * t;
    const float e = __builtin_amdgcn_exp2f((v * v) * (-0.72134752044f));
    const float m = v * (q * e);
    return v < 0.f ? m : v - m;
}

namespace pg8 {
constexpr int BM = 256, BK = 64, HALF = 128, HTB = HALF * BK * 2, STAGE_BYTES = 8 * HTB, NXCD = 8, WGM = 8;
__host__ __device__ __forceinline__ int lds_byte(int r, int c) { const int st = (r >> 4) * 2 + (c >> 5), rr = r & 15, cc = c & 31, ob = rr * 64 + cc * 2; return st * 1024 + (ob ^ (((ob >> 9) & 1) << 5)); }
__host__ __device__ __forceinline__ void stage_rc(int b, int& R, int& C) { const int st = b / 1024, sb = b % 1024, swz = sb ^ (((sb >> 9) & 1) << 5); R = (st >> 1) * 16 + swz / 64; C = (st & 1) * 32 + (swz % 64) / 2; }
__host__ __device__ __forceinline__ int perm32(int rho) { const int n = rho >> 4, i = rho & 15; return 8 * (i >> 2) + 4 * n + (i & 3); }

struct Unit { int pm, pn; };
__device__ __forceinline__ const char* uni(const char* p) { unsigned lo = __builtin_amdgcn_readfirstlane((unsigned)(size_t)p), hi = __builtin_amdgcn_readfirstlane((unsigned)((size_t)p >> 32));
    asm volatile("s_nop 4" : "+s"(lo), "+s"(hi));
    return (const char*)(((size_t)hi << 32) | (size_t)lo); }
struct Gemm { const bf16_t* A; const bf16_t* Bt; int lda, ldb, M, N, K; };

struct StaticOrder {
    int nM, nN, nwg, G, c;
    __device__ void init(int M_, int N_, int G_, int c_) { nM = M_ / BM; nN = N_ / BM; nwg = nM * nN; G = G_; c = c_; }
    __device__ bool next(int i, Unit& u) const {
        const long Lx = (long)i * G + c; if (Lx >= nwg) return false;
        int wgid = (int)Lx; { const int q = nwg / NXCD, r = nwg % NXCD, xcd = wgid % NXCD, off = wgid / NXCD; wgid = (xcd < r ? xcd * (q + 1) : r * (q + 1) + (xcd - r) * q) + off; }
        const int nig = WGM * nN, gid = wgid / nig, fm = gid * WGM, gsz = (nM - fm) < WGM ? (nM - fm) : WGM;
        u.pm = fm + ((wgid % nig) % gsz); u.pn = (wgid % nig) / gsz; return true;
    }
};

template <class Epi, bool ALIGN_EPI, bool MID = false>
__device__ __forceinline__ void gemm_phase(LAS unsigned char* lds, const Gemm g, const StaticOrder& S, const Epi& E) {
    const int tid = opaque_tid(), wid = __builtin_amdgcn_readfirstlane(tid >> 6), lane = tid & 63, wr = wid >> 2, wc = wid & 3, fr = lane & 15, fq = lane >> 4;
    const int K = g.K, nt = K / BK;
    unsigned voffA, voffB;
    { int R, C; stage_rc(tid * 16, R, C); const int Rb = (R & ~31) + perm32(R & 31);
      voffA = (unsigned)(R * g.lda + C) * 2u; voffB = (unsigned)(Rb * g.ldb + C) * 2u; }
    const size_t kstep = (size_t)(BK * 2);
    const size_t hstepA = (size_t)HALF * g.lda * 2, hstepB = (size_t)HALF * g.ldb * 2;
    const size_t tstepA = 2 * hstepA, tstepB = 2 * hstepB;
    const size_t pstepA = hstepA >> 1, pstepB = hstepB >> 1;
    const unsigned ldsbase = (unsigned)(size_t)lds + (unsigned)wid * 1024u;
    const int aoff = lds_byte(wr * 64 + fr, fq * 8), boff = lds_byte(wc * 32 + fr, fq * 8);
#define PG8_SA(b, h) (((b) * 2 + (h)) * HTB)
#define PG8_SB(b, h) ((4 + (b) * 2 + (h)) * HTB)
#define PG8_STAGE_(bufoff, gbase, voff, pstep) do { const char* _g0 = (const char*)(gbase); const char* _g1 = _g0 + (pstep); const unsigned _l0 = ldsbase + (unsigned)(bufoff), _l1 = _l0 + 8192u; \
        asm volatile("s_mov_b32 m0, %2\n\ts_nop 0\n\tglobal_load_lds_dwordx4 %0, %1" :: "v"(voff), "s"(_g0), "s"(_l0) : "memory"); \
        asm volatile("s_mov_b32 m0, %2\n\ts_nop 0\n\tglobal_load_lds_dwordx4 %0, %1" :: "v"(voff), "s"(_g1), "s"(_l1) : "memory"); } while (0)
#define PG8_STAGE(bufoff, gbase, voff) PG8_STAGE_(bufoff, gbase, voff, (&(voff) == &voffA) ? pstepA : pstepB)
#define PG8_LDA(dst, b, h) do { _Pragma("unroll") for (int m = 0; m < 4; ++m) _Pragma("unroll") for (int k = 0; k < 2; ++k) dst[m][k] = *(const LAS bf16x8*)(lds + PG8_SA(b, h) + aoff + m * 2048 + k * 1024); } while (0)
#define PG8_LDB(dst, b, h) do { _Pragma("unroll") for (int n = 0; n < 2; ++n) _Pragma("unroll") for (int k = 0; k < 2; ++k) dst[n][k] = *(const LAS bf16x8*)(lds + PG8_SB(b, h) + boff + n * 2048 + k * 1024); } while (0)
#define PG8_MMA(ai, bj, At, Bt) do { __builtin_amdgcn_s_setprio(1); _Pragma("unroll") for (int m = 0; m < 4; ++m) _Pragma("unroll") for (int n = 0; n < 2; ++n) _Pragma("unroll") for (int k = 0; k < 2; ++k) \
        acc[ai][bj][m][n] = __builtin_amdgcn_mfma_f32_16x16x32_bf16(Bt[n][k], At[m][k], acc[ai][bj][m][n], 0, 0, 0); __builtin_amdgcn_s_setprio(0); } while (0)
#define PG8_WAIT_V(n) asm volatile("s_waitcnt vmcnt(" #n ")" ::: "memory")
#define PG8_WAIT_L(n) asm volatile("s_waitcnt lgkmcnt(" #n ")" ::: "memory")
#define PG8_BAR __builtin_amdgcn_s_barrier()
#define PG8_SCHED __builtin_amdgcn_sched_barrier(0)
    Unit cur, nxt; int ui = 0;
    if (!S.next(0, cur)) return;
    f32x4 acc[2][2][4][2];
#pragma unroll
    for (int a = 0; a < 2; ++a)
#pragma unroll
        for (int b = 0; b < 2; ++b)
#pragma unroll
            for (int m = 0; m < 4; ++m)
#pragma unroll
                for (int n = 0; n < 2; ++n) acc[a][b][m][n] = (f32x4){0.f, 0.f, 0.f, 0.f};
    bf16x8 At[4][2], B0[2][2], B1[2][2];
    const char* cA = uni((const char*)g.A + (size_t)cur.pm * tstepA); const char* cB = uni((const char*)g.Bt + (size_t)cur.pn * tstepB);
    PG8_STAGE(PG8_SB(0, 0), cB, voffB); PG8_STAGE(PG8_SB(0, 1), cB + hstepB, voffB); PG8_STAGE(PG8_SA(0, 0), cA, voffA); PG8_STAGE(PG8_SA(0, 1), cA + hstepA, voffA);
    if (wr == 1) PG8_BAR;
    PG8_WAIT_V(2); PG8_BAR;
    PG8_STAGE(PG8_SB(1, 0), cB + kstep, voffB); PG8_STAGE(PG8_SA(1, 0), cA + kstep, voffA); PG8_STAGE(PG8_SB(1, 1), cB + hstepB + kstep, voffB);
    PG8_WAIT_V(6); PG8_BAR;
    for (;;) {
        const bool has_next = S.next(ui + 1, nxt);
        const char* nA = uni(has_next ? (const char*)g.A + (size_t)nxt.pm * tstepA : cA); const char* nB = uni(has_next ? (const char*)g.Bt + (size_t)nxt.pn * tstepB : cB);
#pragma unroll 1
        for (int t = 0; t < nt; t += 2) {
            const bool last = (t == nt - 2);
            if constexpr (MID) { if (t == (nt >> 1)) E.mid(acc, cur, wr, wc, fr, fq); }
            const char* a1 = cA + (size_t)(t + 1) * kstep;
            const char* a2 = last ? nA : cA + (size_t)(t + 2) * kstep; const char* b2 = last ? nB : cB + (size_t)(t + 2) * kstep;
            const char* a3 = a2 + kstep; const char* b3 = b2 + kstep;
            PG8_LDB(B0, 0, 0); PG8_LDB(B1, 0, 1); PG8_SCHED; PG8_LDA(At, 0, 0); PG8_STAGE(PG8_SA(1, 1), a1 + hstepA, voffA);
            PG8_WAIT_V(8); PG8_WAIT_L(0); PG8_BAR; PG8_MMA(0, 0, At, B0); PG8_MMA(0, 1, At, B1); PG8_BAR; PG8_SCHED;
            PG8_LDA(At, 0, 1); PG8_STAGE(PG8_SB(0, 0), b2, voffB); PG8_STAGE(PG8_SB(0, 1), b2 + hstepB, voffB); PG8_STAGE(PG8_SA(0, 0), a2, voffA);
            PG8_WAIT_V(8); PG8_WAIT_L(0); PG8_BAR; PG8_MMA(1, 0, At, B0); PG8_MMA(1, 1, At, B1); PG8_BAR; PG8_SCHED;
            PG8_LDB(B0, 1, 0); PG8_LDB(B1, 1, 1); PG8_SCHED; PG8_LDA(At, 1, 0); PG8_STAGE(PG8_SA(0, 1), a2 + hstepA, voffA);
            PG8_WAIT_V(8); PG8_WAIT_L(0); PG8_BAR; PG8_MMA(0, 0, At, B0); PG8_MMA(0, 1, At, B1); PG8_BAR; PG8_SCHED;
            PG8_LDA(At, 1, 1); PG8_STAGE(PG8_SB(1, 0), b3, voffB); PG8_STAGE(PG8_SB(1, 1), b3 + hstepB, voffB); PG8_STAGE(PG8_SA(1, 0), a3, voffA);
            PG8_WAIT_V(8); PG8_WAIT_L(0); PG8_BAR; PG8_MMA(1, 0, At, B0); PG8_MMA(1, 1, At, B1); PG8_BAR; PG8_SCHED;
        }
        if constexpr (ALIGN_EPI) { if (wr == 0) PG8_BAR; }
        E(acc, cur, wr, wc, fr, fq);
        if (!has_next) break;
#pragma unroll
        for (int a = 0; a < 2; ++a)
#pragma unroll
            for (int b = 0; b < 2; ++b)
#pragma unroll
                for (int m = 0; m < 4; ++m)
#pragma unroll
                    for (int n = 0; n < 2; ++n) acc[a][b][m][n] = (f32x4){0.f, 0.f, 0.f, 0.f};
        cur = nxt; cA = nA; cB = nB; ++ui;
        if constexpr (ALIGN_EPI) { if (wr == 1) PG8_BAR; }
    }
    PG8_WAIT_V(0);
    if constexpr (!ALIGN_EPI) { if (wr == 0) PG8_BAR; }
    PG8_BAR;
#undef PG8_SA
#undef PG8_SB
#undef PG8_STAGE
#undef PG8_STAGE_
#undef PG8_LDA
#undef PG8_LDB
#undef PG8_MMA
#undef PG8_WAIT_V
#undef PG8_WAIT_L
#undef PG8_BAR
#undef PG8_SCHED
}

#define EPI_LOOP_BEGIN \
    const int row0 = u.pm * BM + wr * 64 + fr, colb = u.pn * BM + wc * 32 + 8 * fq; \
    _Pragma("unroll") for (int ai = 0; ai < 2; ++ai) _Pragma("unroll") for (int m = 0; m < 4; ++m) { const size_t row = (size_t)(row0 + ai * HALF + m * 16); \
    _Pragma("unroll") for (int bj = 0; bj < 2; ++bj) { const int col = colb + bj * HALF; f32x4 v0 = acc[ai][bj][m][0], v1 = acc[ai][bj][m][1];
#define EPI_LOOP_END } if (m & 1) __builtin_amdgcn_sched_barrier(0); }
#define EPI_SIG typedef const f32x4 (&AccT)[2][2][4][2]; __device__ __forceinline__ void operator()(AccT acc, const Unit& u, int wr, int wc, int fr, int fq) const

__device__ __forceinline__ void st_bf16x8(bf16_t* p, f32x4 v0, f32x4 v1) { u32x4 w; w.x = pk2(v0[0], v0[1]); w.y = pk2(v0[2], v0[3]); w.z = pk2(v1[0], v1[1]); w.w = pk2(v1[2], v1[3]); *(u32x4*)p = w; }
__device__ __forceinline__ void ld_bf16x8(const bf16_t* p, f32x4& v0, f32x4& v1) { const u32x4 w = *(const u32x4*)p; v0 = (f32x4){bflo(w.x), bfhi(w.x), bflo(w.y), bfhi(w.y)}; v1 = (f32x4){bflo(w.z), bfhi(w.z), bflo(w.w), bfhi(w.w)}; }

struct EpiInproj { bf16_t *Prw, *Pgm, *G; EPI_SIG {
    bf16_t* base; int ld, cofs; bool sig = false;
    if (u.pn < 7) { base = Prw; ld = RWC; cofs = 0; } else if (u.pn < 11) { base = Pgm; ld = 1024; cofs = 7 * BM; } else { base = G; ld = 2048; cofs = 11 * BM; sig = true; }
    EPI_LOOP_BEGIN
        if (sig) {
#pragma unroll
            for (int j = 0; j < 4; ++j) { v0[j] = sigmoidf_(v0[j]); v1[j] = sigmoidf_(v1[j]); } }
        st_bf16x8(base + row * ld + (col - cofs), v0, v1);
    EPI_LOOP_END
} };
struct EpiLora { bf16_t* OUT; const float *w0, *a0; EPI_SIG {
    const int kind = u.pn >> 1; bf16_t* base = OUT + (size_t)kind * (U / 2) - kind * 512;
    if (kind == 0) {
        EPI_LOOP_BEGIN
            const f32x4 b0 = *(const f32x4*)(w0 + col), b1 = *(const f32x4*)(w0 + col + 4);
#pragma unroll
            for (int j = 0; j < 4; ++j) { v0[j] = omd_of(b0[j] + v0[j]); v1[j] = omd_of(b1[j] + v1[j]); }
            st_bf16x8(base + row * 512 + col, v0, v1);
        EPI_LOOP_END
    } else if (kind == 1) {
        EPI_LOOP_BEGIN
            const f32x4 b0 = *(const f32x4*)(a0 + col - 512), b1 = *(const f32x4*)(a0 + col - 508);
#pragma unroll
            for (int j = 0; j < 4; ++j) { v0[j] = sigmoidf_(b0[j] + v0[j]); v1[j] = sigmoidf_(b1[j] + v1[j]); }
            st_bf16x8(base + row * 512 + col, v0, v1);
        EPI_LOOP_END
    } else {
        EPI_LOOP_BEGIN
            st_bf16x8(base + row * 512 + col, v0, v1);
        EPI_LOOP_END
    }
} };
struct EpiVres { const bf16_t *V0, *VF; bf16_t* V; int ldv; const float* v0res; EPI_SIG {
    EPI_LOOP_BEGIN
        f32x4 a0, a1, f0, f1; ld_bf16x8(V0 + row * 512 + col, a0, a1); ld_bf16x8(VF + row * 512 + col, f0, f1);
        const f32x4 b0 = *(const f32x4*)(v0res + col), b1 = *(const f32x4*)(v0res + col + 4);
#pragma unroll
        for (int j = 0; j < 4; ++j) { v0[j] = a0[j] + (f0[j] - a0[j]) * sigmoidf_(b0[j] + v0[j]); v1[j] = a1[j] + (f1[j] - a1[j]) * sigmoidf_(b1[j] + v1[j]); }
        st_bf16x8(V + row * ldv + col, v0, v1);
    EPI_LOOP_END
} };
struct EpiMergeF { const bf16_t* G; bf16_t* MG;
    __device__ __forceinline__ void mid(f32x4 (&acc)[2][2][4][2], const Unit& u, int wr, int wc, int fr, int fq) const {
        const int row0 = u.pm * BM + wr * 64 + fr, colb = u.pn * BM + wc * 32 + 8 * fq;
#pragma unroll
        for (int ai = 0; ai < 2; ++ai)
#pragma unroll
            for (int m = 0; m < 4; ++m) { const size_t row = (size_t)(row0 + ai * HALF + m * 16);
#pragma unroll
                for (int bj = 0; bj < 2; ++bj) { const int col = colb + bj * HALF;
                    f32x4 ga0, ga1, gb0, gb1; ld_bf16x8(G + row * 2048 + col, ga0, ga1); ld_bf16x8(G + row * 2048 + 1024 + col, gb0, gb1);
#pragma unroll
                    for (int j = 0; j < 4; ++j) { acc[ai][bj][m][0][j] *= gb0[j] * rcpf_(ga0[j]); acc[ai][bj][m][1][j] *= gb1[j] * rcpf_(ga1[j]); } }
                if (m & 1) __builtin_amdgcn_sched_barrier(0); }
    }
    EPI_SIG {
    EPI_LOOP_BEGIN
        f32x4 g0, g1; ld_bf16x8(G + row * 2048 + col, g0, g1);
        st_bf16x8(MG + row * 1024 + col, g0 * v0, g1 * v1);
    EPI_LOOP_END
} };
struct EpiResid { const float* xin; float* xout; const float* gate; EPI_SIG {
    const float* gb = gate + (size_t)(u.pm >> 4) * NMOD;
    EPI_LOOP_BEGIN
        const f32x4 g0 = *(const f32x4*)(gb + col), g1 = *(const f32x4*)(gb + col + 4);
        const f32x4 x0 = *(const f32x4*)(xin + row * 1024 + col), x1 = *(const f32x4*)(xin + row * 1024 + col + 4);
        *(f32x4*)(xout + row * 1024 + col) = x0 + g0 * v0; *(f32x4*)(xout + row * 1024 + col + 4) = x1 + g1 * v1;
    EPI_LOOP_END
} };
struct EpiFF1 { bf16_t* FH; EPI_SIG {
    EPI_LOOP_BEGIN
#pragma unroll
        for (int j = 0; j < 4; ++j) { float a = fmaxf(v0[j], 0.f), b = fmaxf(v1[j], 0.f); v0[j] = a * a; v1[j] = b * b; }
        st_bf16x8(FH + row * 4096 + col, v0, v1);
    EPI_LOOP_END
} };
}

__device__ __forceinline__ void transpose_item(const float* W, int K, int N, bf16_t* WT, int ldo, LAS float* scr, int item, int lane) {
    const int nblk = N / 32, kb = item / nblk, nb = item % nblk, k0 = 64 * kb, n0 = 32 * nb;
    float tv[32];
#pragma unroll
    for (int i = 0; i < 32; ++i) tv[i] = W[(size_t)(k0 + 2 * i + (lane >> 5)) * N + n0 + (lane & 31)];
#pragma unroll
    for (int i = 0; i < 32; ++i) scr[(2 * i + (lane >> 5)) * 33 + (lane & 31)] = tv[i];
    asm volatile("s_waitcnt lgkmcnt(0)" ::: "memory");
    const int c = lane & 7;
#pragma unroll
    for (int j = 0; j < 4; ++j) { const int n = (lane >> 3) + 8 * j; const LAS float* s = scr + (8 * c) * 33 + n;
        u32x4 o; o.x = f2bf(s[0 * 33]) | (f2bf(s[1 * 33]) << 16); o.y = f2bf(s[2 * 33]) | (f2bf(s[3 * 33]) << 16); o.z = f2bf(s[4 * 33]) | (f2bf(s[5 * 33]) << 16); o.w = f2bf(s[6 * 33]) | (f2bf(s[7 * 33]) << 16);
        *(u32x4*)(WT + (size_t)(n0 + n) * ldo + k0 + 8 * c) = o; }
    asm volatile("s_waitcnt lgkmcnt(0)" ::: "memory");
}

__device__ __forceinline__ void prologue(const Params& p, LAS unsigned char* lds, int tid, int lane, int wave, int bid, int G) {
    bf16_t* Wb = (bf16_t*)p.ws;
    {
        LAS float* scr = (LAS float*)(lds + wave * 16384);
        const int gw = bid * 8 + wave, NGW = G * 8;
        constexpr int I_IN = 16 * 152, I_BR = 8 * 32, I_OUT = 16 * 32, I_FF1 = 16 * 128, I_FF2 = 64 * 32, I_L = I_IN + 2 * I_BR + I_OUT + I_FF1 + I_FF2;
        for (int it = gw; it < NL * I_L; it += NGW) {
            const int l = it / I_L; int r = it % I_L; bf16_t* wl = Wb + (size_t)l * LW;
            if (r < I_IN) { transpose_item(GP(p.w_in) + (size_t)l * 1024 * 4864, 1024, 4864, wl + O_IN, 1024, scr, r, lane); continue; } r -= I_IN;
            if (r < I_BR) { transpose_item(GP(p.w_br_rw) + (size_t)l * 512 * 1024, 512, 1024, wl + O_BR1 + 512, 1024, scr, r, lane); continue; } r -= I_BR;
            if (r < I_BR) { transpose_item(GP(p.w_br_gm) + (size_t)l * 512 * 1024, 512, 1024, wl + O_BR1, 1024, scr, r, lane); continue; } r -= I_BR;
            if (r < I_OUT) { transpose_item(GP(p.w_out) + (size_t)l * 1024 * 1024, 1024, 1024, wl + O_OUT, 1024, scr, r, lane); continue; } r -= I_OUT;
            if (r < I_FF1) { transpose_item(GP(p.w_ff1) + (size_t)l * 1024 * 4096, 1024, 4096, wl + O_FF1, 1024, scr, r, lane); continue; } r -= I_FF1;
            transpose_item(GP(p.w_ff2) + (size_t)l * 4096 * 1024, 4096, 1024, wl + O_FF2, 4096, scr, r, lane);
        }
    }
    {
        const int gt = bid * 512 + tid, NT = G * 512;
        for (int idx = gt; idx < NL * 1536 * 256; idx += NT) {
            const int l = idx / (1536 * 256), r = idx % (1536 * 256), n = r >> 8, k = r & 255; float v = 0.f;
            if (n < 512) { if (k < 64) v = GP(p.w2_decay)[((size_t)l * 64 + k) * 512 + n]; }
            else if (n < 1024) { if (k >= 64 && k < 128) v = GP(p.w2_aaa)[((size_t)l * 64 + (k - 64)) * 512 + (n - 512)]; }
            else { if (k >= 128) v = GP(p.w2_gate)[((size_t)l * 128 + (k - 128)) * 512 + (n - 1024)]; }
            Wb[(size_t)l * LW + O_LORA + r] = (bf16_t)f2bf(v);
        }
        for (int idx = gt; idx < (NL - 1) * 512 * 512; idx += NT) {
            const int l1 = idx / (512 * 512), r = idx % (512 * 512), n = r >> 9, k = r & 511; float s = 0.f;
            const float* w1 = GP(p.w1_res) + ((size_t)l1 * 512 + k) * 32; const float* w2 = GP(p.w2_res) + (size_t)l1 * 32 * 512 + n;
            float w1v[32], w2v[32];
#pragma unroll
            for (int q = 0; q < 32; ++q) { w1v[q] = w1[q]; w2v[q] = w2[(size_t)q * 512]; }
#pragma unroll
            for (int q = 0; q < 32; ++q) s += w1v[q] * w2v[q];
            Wb[(size_t)(l1 + 1) * LW + O_V12 + r] = (bf16_t)f2bf(s);
        }
        for (int idx = gt; idx < NL * 4 * 128 * 128; idx += NT) {
            const int l = idx / 65536, r = idx % 65536, i = (r >> 7) & 127, j = r & 127;
            const float v = ((i >> 6) >= (j >> 6)) ? GP(p.w_sp)[idx] : 0.f;
            Wb[(size_t)l * LW + O_WS + r] = (bf16_t)f2bf(v);
        }
    }
    __syncthreads();
    {
        LAS float* cact = (LAS float*)lds; LAS float* part = (LAS float*)(lds + 65536);
        for (int i = tid; i < NB * DM; i += 512) { const float v = GP(p.c)[i]; cact[i] = v * sigmoidf_(v); }
        __syncthreads();
        float* mod = (float*)(p.ws + WS_MOD);
        const int ks = tid >> 6, nl = tid & 63;
        for (int it = bid; it < NL * 96; it += G) {
            const int l = it / 96, n0 = (it % 96) * 64;
            float a[16];
#pragma unroll
            for (int b = 0; b < 16; ++b) a[b] = 0.f;
            const float* wp = GP(p.w_ada) + ((size_t)l * 1024 + ks * 128) * NMOD + n0 + nl;
            for (int k0 = 0; k0 < 128; k0 += 16) { float w[16];
#pragma unroll
                for (int kk = 0; kk < 16; ++kk) w[kk] = wp[(size_t)(k0 + kk) * NMOD];
#pragma unroll
                for (int kk = 0; kk < 16; ++kk)
#pragma unroll
                    for (int b = 0; b < 16; ++b) a[b] += cact[b * 1024 + ks * 128 + k0 + kk] * w[kk]; }
#pragma unroll
            for (int b = 0; b < 16; ++b) part[(ks * 16 + b) * 64 + nl] = a[b];
            __syncthreads();
#pragma unroll
            for (int e = 0; e < 2; ++e) { const int o = tid + 512 * e, b = o >> 6, n2 = o & 63; float s = GP(p.b_ada)[(size_t)l * NMOD + n0 + n2];
#pragma unroll
                for (int q = 0; q < 8; ++q) s += part[(q * 16 + b) * 64 + n2];
                mod[((size_t)l * NB + b) * NMOD + n0 + n2] = s; }
            __syncthreads();
        }
    }
}

__device__ __forceinline__ void norm_phase(const float* __restrict__ x, const float* __restrict__ gain, const float* __restrict__ modl, int shofs, bf16_t* __restrict__ H, int gw, int NGW, int lane) {
    for (int m0 = gw; m0 < M; m0 += 4 * NGW) {
        f32x4 v[4][4]; float s[4];
#pragma unroll
        for (int r = 0; r < 4; ++r) { const f32x4* xr = (const f32x4*)(x + (size_t)(m0 + r * NGW) * DM) + lane;
#pragma unroll
            for (int j = 0; j < 4; ++j) v[r][j] = xr[64 * j]; }
#pragma unroll
        for (int r = 0; r < 4; ++r) { s[r] = 0.f;
#pragma unroll
            for (int j = 0; j < 4; ++j) s[r] += (v[r][j].x * v[r][j].x + v[r][j].y * v[r][j].y) + (v[r][j].z * v[r][j].z + v[r][j].w * v[r][j].w); }
#pragma unroll
        for (int r = 0; r < 4; ++r) { const int m = m0 + r * NGW;
            const float rstd = rsqrtf(wave_sum(s[r]) * (1.f / DM) + 1e-6f);
            const float* mb = modl + (size_t)(m >> 12) * NMOD + shofs;
            u32x2* o = (u32x2*)(H + (size_t)m * DM) + lane;
#pragma unroll
            for (int j = 0; j < 4; ++j) { const int col = 4 * lane + 256 * j;
                const f32x4 g4 = *(const f32x4*)(gain + col), sh = *(const f32x4*)(mb + col), sc = *(const f32x4*)(mb + 1024 + col);
                const f32x4 h = (v[r][j] * rstd * g4) * (sc + 1.f) + sh;
                u32x2 w; w.x = pk2(h.x, h.y); w.y = pk2(h.z, h.w); o[64 * j] = w; } }
    }
}
__device__ __forceinline__ void final_norm(float* x, const float* __restrict__ gain, int gw, int NGW, int lane) {
    for (int m0 = gw; m0 < M; m0 += 4 * NGW) {
        f32x4 v[4][4]; float s[4];
#pragma unroll
        for (int r = 0; r < 4; ++r) { const f32x4* xr = (const f32x4*)(x + (size_t)(m0 + r * NGW) * DM) + lane;
#pragma unroll
            for (int j = 0; j < 4; ++j) v[r][j] = xr[64 * j]; }
#pragma unroll
        for (int r = 0; r < 4; ++r) { s[r] = 0.f;
#pragma unroll
            for (int j = 0; j < 4; ++j) s[r] += (v[r][j].x * v[r][j].x + v[r][j].y * v[r][j].y) + (v[r][j].z * v[r][j].z + v[r][j].w * v[r][j].w); }
#pragma unroll
        for (int r = 0; r < 4; ++r) { f32x4* xr = (f32x4*)(x + (size_t)(m0 + r * NGW) * DM) + lane;
            const float rstd = rsqrtf(wave_sum(s[r]) * (1.f / DM) + 1e-6f);
#pragma unroll
            for (int j = 0; j < 4; ++j) { const f32x4 g4 = *(const f32x4*)(gain + 4 * lane + 256 * j); xr[64 * j] = v[r][j] * rstd * g4; } }
    }
}

__device__ __forceinline__ void prep1_phase(const bf16_t* __restrict__ Prw, const float* __restrict__ mu, bf16_t* __restrict__ R, bf16_t* __restrict__ K0, bf16_t* __restrict__ V0, bf16_t* __restrict__ LIN, int gt, int NT) {
    constexpr int CH = RWC / 8;
    for (int idx0 = gt; idx0 < M * CH; idx0 += 8 * NT) {
        u32x4 cw[8], pw[8]; f32x4 m0[8], m1[8];
#pragma unroll
        for (int u = 0; u < 8; ++u) { const int idx = idx0 + u * NT, m = idx / CH, col = (idx % CH) * 8;
            cw[u] = *(const u32x4*)(Prw + (size_t)m * RWC + col);
            pw[u] = ((m & (SEQ - 1)) != 0) ? *(const u32x4*)(Prw + (size_t)(m - 1) * RWC + col) : (u32x4){0u, 0u, 0u, 0u};
            m0[u] = *(const f32x4*)(mu + col); m1[u] = *(const f32x4*)(mu + col + 4); }
#pragma unroll
        for (int u = 0; u < 8; ++u) { const int idx = idx0 + u * NT, m = idx / CH, col = (idx % CH) * 8;
            const f32x4 c0 = (f32x4){bflo(cw[u].x), bfhi(cw[u].x), bflo(cw[u].y), bfhi(cw[u].y)}, c1 = (f32x4){bflo(cw[u].z), bfhi(cw[u].z), bflo(cw[u].w), bfhi(cw[u].w)};
            const f32x4 p0 = (f32x4){bflo(pw[u].x), bfhi(pw[u].x), bflo(pw[u].y), bfhi(pw[u].y)}, p1 = (f32x4){bflo(pw[u].z), bfhi(pw[u].z), bflo(pw[u].w), bfhi(pw[u].w)};
            f32x4 x0 = c0 + (p0 - c0) * m0[u], x1 = c1 + (p1 - c1) * m1[u];
            bf16_t* dst;
            if (col < 512) dst = R + (size_t)m * 512 + col;
            else if (col < 1024) dst = K0 + (size_t)m * 512 + (col - 512);
            else if (col < 1536) dst = V0 + (size_t)m * 512 + (col - 1024);
            else { dst = LIN + (size_t)m * 256 + (col - 1536);
                if (col < 1600) {
#pragma unroll
                    for (int j = 0; j < 4; ++j) { x0[j] = tanhf_(x0[j]); x1[j] = tanhf_(x1[j]); } }
                else if (col >= 1664) {
#pragma unroll
                    for (int j = 0; j < 4; ++j) { x0[j] = sigmoidf_(x0[j]); x1[j] = sigmoidf_(x1[j]); } } }
            pg8::st_bf16x8(dst, x0, x1); }
    }
}

__device__ __forceinline__ void gmlp_item(LAS unsigned char* lds, bf16_t* Pgm, bf16_t* Yo, const bf16_t* __restrict__ Wsm, const float* __restrict__ lnw, const float* __restrict__ lnb, const float* __restrict__ bsp, int item, int tid, int lane, int wave) {
    LAS float* stats = (LAS float*)lds;
    LAS bf16_t* Vs = (LAS bf16_t*)(lds + 1024);
    constexpr int VP = 130;
    const size_t m0 = (size_t)item * 128;
#pragma unroll
    for (int hb = 0; hb < 2; ++hb) {
        u32x4 raw[8];
#pragma unroll
        for (int e = 0; e < 8; ++e) raw[e] = *(const u32x4*)(Pgm + (m0 + wave * 16 + hb * 8 + e) * 1024 + 512 + lane * 8);
#pragma unroll
        for (int e = 0; e < 8; ++e) { const int tk = wave * 16 + hb * 8 + e; float s = 0.f, ss = 0.f;
            const unsigned w4[4] = {raw[e].x, raw[e].y, raw[e].z, raw[e].w};
#pragma unroll
            for (int j = 0; j < 4; ++j) { const float g0 = gelu1(bflo(w4[j])), g1 = gelu1(bfhi(w4[j])); s += g0 + g1; ss += g0 * g0 + g1 * g1; }
            s = wave_sum(s); ss = wave_sum(ss);
            const float mean = s * (1.f / 512.f), var = fmaxf(ss * (1.f / 512.f) - mean * mean, 0.f);
            if (lane == 0) { stats[tk * 2] = mean; stats[tk * 2 + 1] = rsqrtf(var + 1e-5f); } }
    }
    __syncthreads();
    const int fr = lane & 15, fq = lane >> 4;
    const int i = 16 * wave + fr;
#pragma unroll 1
    for (int g = 0; g < 4; ++g) {
        u32x4 vraw[4]; bf16x8 af[4]; u32x2 uw[8];
#pragma unroll
        for (int it = 0; it < 4; ++it) { const int q = tid + 512 * it, j = q >> 4, dc = q & 15; vraw[it] = *(const u32x4*)(Pgm + (m0 + j) * 1024 + 512 + g * 128 + dc * 8); }
#pragma unroll
        for (int kc = 0; kc < 4; ++kc) af[kc] = *(const bf16x8*)(Wsm + ((size_t)g * 128 + i) * 128 + kc * 32 + fq * 8);
        bf16_t* urow = Pgm + (m0 + i) * 1024 + g * 128 + fq * 4;
#pragma unroll
        for (int dt = 0; dt < 8; ++dt) uw[dt] = *(const u32x2*)(urow + dt * 16);
        const float bs = bsp[g * 128 + i];
#pragma unroll
        for (int it = 0; it < 4; ++it) { const int q = tid + 512 * it, j = q >> 4, dc = q & 15;
            const float mean = stats[j * 2], rstd = stats[j * 2 + 1];
            const f32x4 w0 = *(const f32x4*)(lnw + g * 128 + dc * 8), w1 = *(const f32x4*)(lnw + g * 128 + dc * 8 + 4);
            const f32x4 b0 = *(const f32x4*)(lnb + g * 128 + dc * 8), b1 = *(const f32x4*)(lnb + g * 128 + dc * 8 + 4);
            f32x4 a0 = (f32x4){bflo(vraw[it].x), bfhi(vraw[it].x), bflo(vraw[it].y), bfhi(vraw[it].y)}, a1 = (f32x4){bflo(vraw[it].z), bfhi(vraw[it].z), bflo(vraw[it].w), bfhi(vraw[it].w)};
#pragma unroll
            for (int e = 0; e < 4; ++e) { a0[e] = (gelu1(a0[e]) - mean) * rstd * w0[e] + b0[e]; a1[e] = (gelu1(a1[e]) - mean) * rstd * w1[e] + b1[e]; }
            LAS unsigned* dst = (LAS unsigned*)(Vs + j * VP + dc * 8);
            dst[0] = pk2(a0[0], a0[1]); dst[1] = pk2(a0[2], a0[3]); dst[2] = pk2(a1[0], a1[1]); dst[3] = pk2(a1[2], a1[3]); }
        __syncthreads();
        f32x4 acc[8];
#pragma unroll
        for (int dt = 0; dt < 8; ++dt) { acc[dt] = (f32x4){0.f, 0.f, 0.f, 0.f};
#pragma unroll
            for (int kc = 0; kc < 4; ++kc) { bf16x8 bfv;
#pragma unroll
                for (int e = 0; e < 8; ++e) bfv[e] = (short)Vs[(kc * 32 + fq * 8 + e) * VP + dt * 16 + fr];
                acc[dt] = __builtin_amdgcn_mfma_f32_16x16x32_bf16(bfv, af[kc], acc[dt], 0, 0, 0); } }
#pragma unroll
        for (int dt = 0; dt < 8; ++dt) {
            const float y0 = gelu1(bflo(uw[dt].x)) * (acc[dt][0] + bs), y1 = gelu1(bfhi(uw[dt].x)) * (acc[dt][1] + bs), y2 = gelu1(bflo(uw[dt].y)) * (acc[dt][2] + bs), y3 = gelu1(bfhi(uw[dt].y)) * (acc[dt][3] + bs);
            u32x2 o; o.x = pk2(y0, y1); o.y = pk2(y2, y3); *(u32x2*)(Yo + (m0 + i) * 1024 + g * 128 + fq * 4 + dt * 16) = o; }
        __syncthreads();
    }
}

__device__ __forceinline__ void scan_phase(LAS unsigned char* lds, const bf16_t* __restrict__ R, const bf16_t* __restrict__ K0, const bf16_t* __restrict__ AS, const bf16_t* __restrict__ OMD, const bf16_t* __restrict__ V, int ldv,
                                           bf16_t* __restrict__ Y, float* __restrict__ CB, const float* k_k, const float* k_a, const float* r_k, const float* w0p, const float* a0p, int bid, int tid) {
    constexpr int CT = 32, VF32 = CT * 64, BUFF = 6 * VF32;
    LAS float* buf = (LAS float*)lds;
    LAS float* ybuf = (LAS float*)(lds + 2 * BUFF * 4);
    const int bh = bid >> 1, half = bid & 1, b = bh >> 3, h = bh & 7;
    const int lane = tid & 63, wave = __builtin_amdgcn_readfirstlane(tid >> 6);
    const size_t mrow0 = (size_t)b * SEQ;
    constexpr int NCH = SEQ / CT;
    if (wave >= 4) {
        const int lt = tid - 256, tt = lt >> 4, jg = lt & 15, jl = 4 * jg, colL = h * 64 + jl;
        const f32x4 kk4 = *(const f32x4*)(k_k + colL), ka4 = *(const f32x4*)(k_a + colL), rk4 = *(const f32x4*)(r_k + colL), wz4 = *(const f32x4*)(w0p + colL), az4 = *(const f32x4*)(a0p + colL);
        u32x2 Pr0, Pk0, Pa0, Po0, Pv0, Pr1, Pk1, Pa1, Po1, Pv1;
#define SCAN_LOAD1(c, tk, Pr, Pk, Pa, Po, Pv) do { const size_t m_ = mrow0 + (size_t)(c) * CT + (tk); \
        Pr = *(const u32x2*)(R + m_ * 512 + colL); Pk = *(const u32x2*)(K0 + m_ * 512 + colL); Pa = *(const u32x2*)(AS + m_ * 512 + colL); \
        Po = *(const u32x2*)(OMD + m_ * 512 + colL); Pv = *(const u32x2*)(V + m_ * (size_t)ldv + colL); } while (0)
#define SCAN_LOAD(c) do { SCAN_LOAD1(c, tt, Pr0, Pk0, Pa0, Po0, Pv0); SCAN_LOAD1(c, tt + 16, Pr1, Pk1, Pa1, Po1, Pv1); } while (0)
#define SCAN_FILL1(c, nb, tk, Pr, Pk, Pa, Po, Pv) do { LAS float* B_ = buf + (nb) * BUFF + (tk) * 64 + jl; \
        const f32x4 r4 = (f32x4){bflo(Pr.x), bfhi(Pr.x), bflo(Pr.y), bfhi(Pr.y)}, k4 = (f32x4){bflo(Pk.x), bfhi(Pk.x), bflo(Pk.y), bfhi(Pk.y)}; \
        const f32x4 al = (f32x4){bflo(Pa.x), bfhi(Pa.x), bflo(Pa.y), bfhi(Pa.y)}, ol = (f32x4){bflo(Po.x), bfhi(Po.x), bflo(Po.y), bfhi(Po.y)}; \
        f32x4 a4, w4; a4 = al; w4 = 1.f - ol; \
        const f32x4 q4 = k4 * kk4; const float ssq = row_sum16((q4.x * q4.x + q4.y * q4.y) + (q4.z * q4.z + q4.w * q4.w)); const float inv = 1.f / fmaxf(sqrtf(ssq), 1e-12f); \
        const f32x4 n4 = q4 * inv; const f32x4 km4 = k4 * ((a4 - 1.f) * ka4 + 1.f); const f32x4 bo4 = r4 * km4 * rk4; \
        const float bon = row_sum16((bo4.x + bo4.y) + (bo4.z + bo4.w)); \
        *(LAS f32x4*)(B_ + 0 * VF32) = w4; *(LAS f32x4*)(B_ + 1 * VF32) = -n4; *(LAS f32x4*)(B_ + 2 * VF32) = n4 * a4; *(LAS f32x4*)(B_ + 3 * VF32) = km4; *(LAS f32x4*)(B_ + 4 * VF32) = r4; \
        *(LAS f32x4*)(B_ + 5 * VF32) = (f32x4){bflo(Pv.x), bfhi(Pv.x), bflo(Pv.y), bfhi(Pv.y)}; \
        if (half == 0 && jg == 0) CB[(mrow0 + (size_t)(c) * CT + (tk)) * 8 + h] = bon; } while (0)
#define SCAN_FILL(c, nb) do { SCAN_FILL1(c, nb, tt, Pr0, Pk0, Pa0, Po0, Pv0); SCAN_FILL1(c, nb, tt + 16, Pr1, Pk1, Pa1, Po1, Pv1); } while (0)
#define SCAN_WRITE(c, yb_) do { const int t2_ = lt >> 3, ip_ = lt & 7; const size_t m_ = mrow0 + (size_t)(c) * CT + t2_; \
        const f32x4 yy_ = *(const LAS f32x4*)((yb_) + t2_ * 32 + 4 * ip_); u32x2 o_; o_.x = pk2(yy_.x, yy_.y); o_.y = pk2(yy_.z, yy_.w); *(u32x2*)(Y + m_ * 512 + h * 64 + half * 32 + 4 * ip_) = o_; } while (0)
        SCAN_LOAD(0); SCAN_FILL(0, 0); SCAN_LOAD(1);
        __syncthreads();
#pragma unroll 1
        for (int c = 0; c < NCH; ++c) {
            const int cur = c & 1;
            if (c > 0) SCAN_WRITE(c - 1, ybuf + (cur ^ 1) * (CT * 32));
            if (c + 1 < NCH) { SCAN_FILL(c + 1, cur ^ 1); if (c + 2 < NCH) SCAN_LOAD(c + 2); }
            __syncthreads();
        }
        SCAN_WRITE(NCH - 1, ybuf + ((NCH - 1) & 1) * (CT * 32));
#undef SCAN_LOAD1
#undef SCAN_LOAD
#undef SCAN_FILL1
#undef SCAN_FILL
#undef SCAN_WRITE
    } else {
        const int rloc = wave * 8 + (lane >> 3), irow = half * 32 + rloc, jq = lane & 7, j0 = jq * 8;
        f32x2 s0 = (f32x2){0.f, 0.f}, s1 = s0, s2 = s0, s3 = s0;
        const unsigned lds0 = (unsigned)(size_t)buf;
        __syncthreads();
#define DSR128(dst, addr, off) asm volatile("ds_read_b128 %0, %1 offset:%2" : "=v"(dst) : "v"(addr), "n"(off))
#define DSR32(dst, addr, off) asm volatile("ds_read_b32 %0, %1 offset:%2" : "=v"(dst) : "v"(addr), "n"(off))
#define SC_PART1(PE) const f32x2 pa = (s0 * (f32x2){PE##A0.x, PE##A0.y} + s1 * (f32x2){PE##A0.z, PE##A0.w}) + (s2 * (f32x2){PE##A1.x, PE##A1.y} + s3 * (f32x2){PE##A1.z, PE##A1.w}); \
                const f32x2 v2 = (f32x2){PE##v, PE##v}; \
                const f32x2 t0 = s0 * (f32x2){PE##W0.x, PE##W0.y} + v2 * (f32x2){PE##K0.x, PE##K0.y}, t1 = s1 * (f32x2){PE##W0.z, PE##W0.w} + v2 * (f32x2){PE##K0.z, PE##K0.w}; \
                const f32x2 t2 = s2 * (f32x2){PE##W1.x, PE##W1.y} + v2 * (f32x2){PE##K1.x, PE##K1.y}, t3 = s3 * (f32x2){PE##W1.z, PE##W1.w} + v2 * (f32x2){PE##K1.z, PE##K1.w}; \
                const float sa = red8(pa.x + pa.y); const f32x2 sa2 = (f32x2){sa, sa};
#define SC_PART2(PL, tq_, yk_) s0 = t0 + sa2 * (f32x2){PL##B0.x, PL##B0.y}; s1 = t1 + sa2 * (f32x2){PL##B0.z, PL##B0.w}; s2 = t2 + sa2 * (f32x2){PL##B1.x, PL##B1.y}; s3 = t3 + sa2 * (f32x2){PL##B1.z, PL##B1.w}; \
                { const f32x2 py = (s0 * (f32x2){PL##R0.x, PL##R0.y} + s1 * (f32x2){PL##R0.z, PL##R0.w}) + (s2 * (f32x2){PL##R1.x, PL##R1.y} + s3 * (f32x2){PL##R1.z, PL##R1.w}); \
                  const float y = red8(py.x + py.y); yk_ = (jq == (tq_)) ? y : yk_; }
#pragma unroll 1
        for (int c = 0; c < NCH; ++c) {
            const int cur = c & 1;
            LAS float* yb = ybuf + cur * (CT * 32);
            float yk0 = 0.f, yk1 = 0.f, yk2 = 0.f, yk3 = 0.f;
            const unsigned qa = lds0 + (unsigned)(cur * BUFF + j0) * 4u, va = lds0 + (unsigned)(cur * BUFF + 5 * VF32 + irow) * 4u;
            f32x4 EAA0, EAA1, EAW0, EAW1, EAK0, EAK1, EBA0, EBA1, EBW0, EBW1, EBK0, EBK1, ECA0, ECA1, ECW0, ECW1, ECK0, ECK1, LAB0, LAB1, LAR0, LAR1, LBB0, LBB1, LBR0, LBR1; float EAv, EBv, ECv;
            DSR128(EAA0, qa, 8192); DSR128(EAA1, qa, 8208); DSR128(EAW0, qa, 0); DSR128(EAW1, qa, 16); DSR128(EAK0, qa, 24576); DSR128(EAK1, qa, 24592); DSR32(EAv, va, 0); DSR128(LAB0, qa, 16384); DSR128(LAB1, qa, 16400); DSR128(LAR0, qa, 32768); DSR128(LAR1, qa, 32784); DSR128(EBA0, qa, 8448); DSR128(EBA1, qa, 8464); DSR128(EBW0, qa, 256); DSR128(EBW1, qa, 272); DSR128(EBK0, qa, 24832); DSR128(EBK1, qa, 24848); DSR32(EBv, va, 256);
            { asm volatile("s_waitcnt lgkmcnt(11)" : "+v"(EAA0), "+v"(EAA1), "+v"(EAW0), "+v"(EAW1), "+v"(EAK0), "+v"(EAK1), "+v"(EAv)); DSR128(LBB0, qa, 16640); DSR128(LBB1, qa, 16656); DSR128(LBR0, qa, 33024); DSR128(LBR1, qa, 33040); DSR128(ECA0, qa, 8704); DSR128(ECA1, qa, 8720); DSR128(ECW0, qa, 512); DSR128(ECW1, qa, 528); DSR128(ECK0, qa, 25088); DSR128(ECK1, qa, 25104); DSR32(ECv, va, 512); SC_PART1(EA) asm volatile("s_waitcnt lgkmcnt(15)" : "+v"(LAB0), "+v"(LAB1), "+v"(LAR0), "+v"(LAR1)); SC_PART2(LA, 0, yk0) }
            { asm volatile("s_waitcnt lgkmcnt(11)" : "+v"(EBA0), "+v"(EBA1), "+v"(EBW0), "+v"(EBW1), "+v"(EBK0), "+v"(EBK1), "+v"(EBv)); DSR128(LAB0, qa, 16896); DSR128(LAB1, qa, 16912); DSR128(LAR0, qa, 33280); DSR128(LAR1, qa, 33296); DSR128(EAA0, qa, 8960); DSR128(EAA1, qa, 8976); DSR128(EAW0, qa, 768); DSR128(EAW1, qa, 784); DSR128(EAK0, qa, 25344); DSR128(EAK1, qa, 25360); DSR32(EAv, va, 768); SC_PART1(EB) asm volatile("s_waitcnt lgkmcnt(15)" : "+v"(LBB0), "+v"(LBB1), "+v"(LBR0), "+v"(LBR1)); SC_PART2(LB, 1, yk0) }
            { asm volatile("s_waitcnt lgkmcnt(11)" : "+v"(ECA0), "+v"(ECA1), "+v"(ECW0), "+v"(ECW1), "+v"(ECK0), "+v"(ECK1), "+v"(ECv)); DSR128(LBB0, qa, 17152); DSR128(LBB1, qa, 17168); DSR128(LBR0, qa, 33536); DSR128(LBR1, qa, 33552); DSR128(EBA0, qa, 9216); DSR128(EBA1, qa, 9232); DSR128(EBW0, qa, 1024); DSR128(EBW1, qa, 1040); DSR128(EBK0, qa, 25600); DSR128(EBK1, qa, 25616); DSR32(EBv, va, 1024); SC_PART1(EC) asm volatile("s_waitcnt lgkmcnt(15)" : "+v"(LAB0), "+v"(LAB1), "+v"(LAR0), "+v"(LAR1)); SC_PART2(LA, 2, yk0) }
            { asm volatile("s_waitcnt lgkmcnt(11)" : "+v"(EAA0), "+v"(EAA1), "+v"(EAW0), "+v"(EAW1), "+v"(EAK0), "+v"(EAK1), "+v"(EAv)); DSR128(LAB0, qa, 17408); DSR128(LAB1, qa, 17424); DSR128(LAR0, qa, 33792); DSR128(LAR1, qa, 33808); DSR128(ECA0, qa, 9472); DSR128(ECA1, qa, 9488); DSR128(ECW0, qa, 1280); DSR128(ECW1, qa, 1296); DSR128(ECK0, qa, 25856); DSR128(ECK1, qa, 25872); DSR32(ECv, va, 1280); SC_PART1(EA) asm volatile("s_waitcnt lgkmcnt(15)" : "+v"(LBB0), "+v"(LBB1), "+v"(LBR0), "+v"(LBR1)); SC_PART2(LB, 3, yk0) }
            { asm volatile("s_waitcnt lgkmcnt(11)" : "+v"(EBA0), "+v"(EBA1), "+v"(EBW0), "+v"(EBW1), "+v"(EBK0), "+v"(EBK1), "+v"(EBv)); DSR128(LBB0, qa, 17664); DSR128(LBB1, qa, 17680); DSR128(LBR0, qa, 34048); DSR128(LBR1, qa, 34064); DSR128(EAA0, qa, 9728); DSR128(EAA1, qa, 9744); DSR128(EAW0, qa, 1536); DSR128(EAW1, qa, 1552); DSR128(EAK0, qa, 26112); DSR128(EAK1, qa, 26128); DSR32(EAv, va, 1536); SC_PART1(EB) asm volatile("s_waitcnt lgkmcnt(15)" : "+v"(LAB0), "+v"(LAB1), "+v"(LAR0), "+v"(LAR1)); SC_PART2(LA, 4, yk0) }
            { asm volatile("s_waitcnt lgkmcnt(11)" : "+v"(ECA0), "+v"(ECA1), "+v"(ECW0), "+v"(ECW1), "+v"(ECK0), "+v"(ECK1), "+v"(ECv)); DSR128(LAB0, qa, 17920); DSR128(LAB1, qa, 17936); DSR128(LAR0, qa, 34304); DSR128(LAR1, qa, 34320); DSR128(EBA0, qa, 9984); DSR128(EBA1, qa, 10000); DSR128(EBW0, qa, 1792); DSR128(EBW1, qa, 1808); DSR128(EBK0, qa, 26368); DSR128(EBK1, qa, 26384); DSR32(EBv, va, 1792); SC_PART1(EC) asm volatile("s_waitcnt lgkmcnt(15)" : "+v"(LBB0), "+v"(LBB1), "+v"(LBR0), "+v"(LBR1)); SC_PART2(LB, 5, yk0) }
            { asm volatile("s_waitcnt lgkmcnt(11)" : "+v"(EAA0), "+v"(EAA1), "+v"(EAW0), "+v"(EAW1), "+v"(EAK0), "+v"(EAK1), "+v"(EAv)); DSR128(LBB0, qa, 18176); DSR128(LBB1, qa, 18192); DSR128(LBR0, qa, 34560); DSR128(LBR1, qa, 34576); DSR128(ECA0, qa, 10240); DSR128(ECA1, qa, 10256); DSR128(ECW0, qa, 2048); DSR128(ECW1, qa, 2064); DSR128(ECK0, qa, 26624); DSR128(ECK1, qa, 26640); DSR32(ECv, va, 2048); SC_PART1(EA) asm volatile("s_waitcnt lgkmcnt(15)" : "+v"(LAB0), "+v"(LAB1), "+v"(LAR0), "+v"(LAR1)); SC_PART2(LA, 6, yk0) }
            { asm volatile("s_waitcnt lgkmcnt(11)" : "+v"(EBA0), "+v"(EBA1), "+v"(EBW0), "+v"(EBW1), "+v"(EBK0), "+v"(EBK1), "+v"(EBv)); DSR128(LAB0, qa, 18432); DSR128(LAB1, qa, 18448); DSR128(LAR0, qa, 34816); DSR128(LAR1, qa, 34832); DSR128(EAA0, qa, 10496); DSR128(EAA1, qa, 10512); DSR128(EAW0, qa, 2304); DSR128(EAW1, qa, 2320); DSR128(EAK0, qa, 26880); DSR128(EAK1, qa, 26896); DSR32(EAv, va, 2304); SC_PART1(EB) asm volatile("s_waitcnt lgkmcnt(15)" : "+v"(LBB0), "+v"(LBB1), "+v"(LBR0), "+v"(LBR1)); SC_PART2(LB, 7, yk0) }
            { asm volatile("s_waitcnt lgkmcnt(11)" : "+v"(ECA0), "+v"(ECA1), "+v"(ECW0), "+v"(ECW1), "+v"(ECK0), "+v"(ECK1), "+v"(ECv)); DSR128(LBB0, qa, 18688); DSR128(LBB1, qa, 18704); DSR128(LBR0, qa, 35072); DSR128(LBR1, qa, 35088); DSR128(EBA0, qa, 10752); DSR128(EBA1, qa, 10768); DSR128(EBW0, qa, 2560); DSR128(EBW1, qa, 2576); DSR128(EBK0, qa, 27136); DSR128(EBK1, qa, 27152); DSR32(EBv, va, 2560); SC_PART1(EC) asm volatile("s_waitcnt lgkmcnt(15)" : "+v"(LAB0), "+v"(LAB1), "+v"(LAR0), "+v"(LAR1)); SC_PART2(LA, 0, yk1) }
            { asm volatile("s_waitcnt lgkmcnt(11)" : "+v"(EAA0), "+v"(EAA1), "+v"(EAW0), "+v"(EAW1), "+v"(EAK0), "+v"(EAK1), "+v"(EAv)); DSR128(LAB0, qa, 18944); DSR128(LAB1, qa, 18960); DSR128(LAR0, qa, 35328); DSR128(LAR1, qa, 35344); DSR128(ECA0, qa, 11008); DSR128(ECA1, qa, 11024); DSR128(ECW0, qa, 2816); DSR128(ECW1, qa, 2832); DSR128(ECK0, qa, 27392); DSR128(ECK1, qa, 27408); DSR32(ECv, va, 2816); SC_PART1(EA) asm volatile("s_waitcnt lgkmcnt(15)" : "+v"(LBB0), "+v"(LBB1), "+v"(LBR0), "+v"(LBR1)); SC_PART2(LB, 1, yk1) }
            { asm volatile("s_waitcnt lgkmcnt(11)" : "+v"(EBA0), "+v"(EBA1), "+v"(EBW0), "+v"(EBW1), "+v"(EBK0), "+v"(EBK1), "+v"(EBv)); DSR128(LBB0, qa, 19200); DSR128(LBB1, qa, 19216); DSR128(LBR0, qa, 35584); DSR128(LBR1, qa, 35600); DSR128(EAA0, qa, 11264); DSR128(EAA1, qa, 11280); DSR128(EAW0, qa, 3072); DSR128(EAW1, qa, 3088); DSR128(EAK0, qa, 27648); DSR128(EAK1, qa, 27664); DSR32(EAv, va, 3072); SC_PART1(EB) asm volatile("s_waitcnt lgkmcnt(15)" : "+v"(LAB0), "+v"(LAB1), "+v"(LAR0), "+v"(LAR1)); SC_PART2(LA, 2, yk1) }
            { asm volatile("s_waitcnt lgkmcnt(11)" : "+v"(ECA0), "+v"(ECA1), "+v"(ECW0), "+v"(ECW1), "+v"(ECK0), "+v"(ECK1), "+v"(ECv)); DSR128(LAB0, qa, 19456); DSR128(LAB1, qa, 19472); DSR128(LAR0, qa, 35840); DSR128(LAR1, qa, 35856); DSR128(EBA0, qa, 11520); DSR128(EBA1, qa, 11536); DSR128(EBW0, qa, 3328); DSR128(EBW1, qa, 3344); DSR128(EBK0, qa, 27904); DSR128(EBK1, qa, 27920); DSR32(EBv, va, 3328); SC_PART1(EC) asm volatile("s_waitcnt lgkmcnt(15)" : "+v"(LBB0), "+v"(LBB1), "+v"(LBR0), "+v"(LBR1)); SC_PART2(LB, 3, yk1) }
            { asm volatile("s_waitcnt lgkmcnt(11)" : "+v"(EAA0), "+v"(EAA1), "+v"(EAW0), "+v"(EAW1), "+v"(EAK0), "+v"(EAK1), "+v"(EAv)); DSR128(LBB0, qa, 19712); DSR128(LBB1, qa, 19728); DSR128(LBR0, qa, 36096); DSR128(LBR1, qa, 36112); DSR128(ECA0, qa, 11776); DSR128(ECA1, qa, 11792); DSR128(ECW0, qa, 3584); DSR128(ECW1, qa, 3600); DSR128(ECK0, qa, 28160); DSR128(ECK1, qa, 28176); DSR32(ECv, va, 3584); SC_PART1(EA) asm volatile("s_waitcnt lgkmcnt(15)" : "+v"(LAB0), "+v"(LAB1), "+v"(LAR0), "+v"(LAR1)); SC_PART2(LA, 4, yk1) }
            { asm volatile("s_waitcnt lgkmcnt(11)" : "+v"(EBA0), "+v"(EBA1), "+v"(EBW0), "+v"(EBW1), "+v"(EBK0), "+v"(EBK1), "+v"(EBv)); DSR128(LAB0, qa, 19968); DSR128(LAB1, qa, 19984); DSR128(LAR0, qa, 36352); DSR128(LAR1, qa, 36368); DSR128(EAA0, qa, 12032); DSR128(EAA1, qa, 12048); DSR128(EAW0, qa, 3840); DSR128(EAW1, qa, 3856); DSR128(EAK0, qa, 28416); DSR128(EAK1, qa, 28432); DSR32(EAv, va, 3840); SC_PART1(EB) asm volatile("s_waitcnt lgkmcnt(15)" : "+v"(LBB0), "+v"(LBB1), "+v"(LBR0), "+v"(LBR1)); SC_PART2(LB, 5, yk1) }
            { asm volatile("s_waitcnt lgkmcnt(11)" : "+v"(ECA0), "+v"(ECA1), "+v"(ECW0), "+v"(ECW1), "+v"(ECK0), "+v"(ECK1), "+v"(ECv)); DSR128(LBB0, qa, 20224); DSR128(LBB1, qa, 20240); DSR128(LBR0, qa, 36608); DSR128(LBR1, qa, 36624); DSR128(EBA0, qa, 12288); DSR128(EBA1, qa, 12304); DSR128(EBW0, qa, 4096); DSR128(EBW1, qa, 4112); DSR128(EBK0, qa, 28672); DSR128(EBK1, qa, 28688); DSR32(EBv, va, 4096); SC_PART1(EC) asm volatile("s_waitcnt lgkmcnt(15)" : "+v"(LAB0), "+v"(LAB1), "+v"(LAR0), "+v"(LAR1)); SC_PART2(LA, 6, yk1) }
            { asm volatile("s_waitcnt lgkmcnt(11)" : "+v"(EAA0), "+v"(EAA1), "+v"(EAW0), "+v"(EAW1), "+v"(EAK0), "+v"(EAK1), "+v"(EAv)); DSR128(LAB0, qa, 20480); DSR128(LAB1, qa, 20496); DSR128(LAR0, qa, 36864); DSR128(LAR1, qa, 36880); DSR128(ECA0, qa, 12544); DSR128(ECA1, qa, 12560); DSR128(ECW0, qa, 4352); DSR128(ECW1, qa, 4368); DSR128(ECK0, qa, 28928); DSR128(ECK1, qa, 28944); DSR32(ECv, va, 4352); SC_PART1(EA) asm volatile("s_waitcnt lgkmcnt(15)" : "+v"(LBB0), "+v"(LBB1), "+v"(LBR0), "+v"(LBR1)); SC_PART2(LB, 7, yk1) }
            { asm volatile("s_waitcnt lgkmcnt(11)" : "+v"(EBA0), "+v"(EBA1), "+v"(EBW0), "+v"(EBW1), "+v"(EBK0), "+v"(EBK1), "+v"(EBv)); DSR128(LBB0, qa, 20736); DSR128(LBB1, qa, 20752); DSR128(LBR0, qa, 37120); DSR128(LBR1, qa, 37136); DSR128(EAA0, qa, 12800); DSR128(EAA1, qa, 12816); DSR128(EAW0, qa, 4608); DSR128(EAW1, qa, 4624); DSR128(EAK0, qa, 29184); DSR128(EAK1, qa, 29200); DSR32(EAv, va, 4608); SC_PART1(EB) asm volatile("s_waitcnt lgkmcnt(15)" : "+v"(LAB0), "+v"(LAB1), "+v"(LAR0), "+v"(LAR1)); SC_PART2(LA, 0, yk2) }
            { asm volatile("s_waitcnt lgkmcnt(11)" : "+v"(ECA0), "+v"(ECA1), "+v"(ECW0), "+v"(ECW1), "+v"(ECK0), "+v"(ECK1), "+v"(ECv)); DSR128(LAB0, qa, 20992); DSR128(LAB1, qa, 21008); DSR128(LAR0, qa, 37376); DSR128(LAR1, qa, 37392); DSR128(EBA0, qa, 13056); DSR128(EBA1, qa, 13072); DSR128(EBW0, qa, 4864); DSR128(EBW1, qa, 4880); DSR128(EBK0, qa, 29440); DSR128(EBK1, qa, 29456); DSR32(EBv, va, 4864); SC_PART1(EC) asm volatile("s_waitcnt lgkmcnt(15)" : "+v"(LBB0), "+v"(LBB1), "+v"(LBR0), "+v"(LBR1)); SC_PART2(LB, 1, yk2) }
            { asm volatile("s_waitcnt lgkmcnt(11)" : "+v"(EAA0), "+v"(EAA1), "+v"(EAW0), "+v"(EAW1), "+v"(EAK0), "+v"(EAK1), "+v"(EAv)); DSR128(LBB0, qa, 21248); DSR128(LBB1, qa, 21264); DSR128(LBR0, qa, 37632); DSR128(LBR1, qa, 37648); DSR128(ECA0, qa, 13312); DSR128(ECA1, qa, 13328); DSR128(ECW0, qa, 5120); DSR128(ECW1, qa, 5136); DSR128(ECK0, qa, 29696); DSR128(ECK1, qa, 29712); DSR32(ECv, va, 5120); SC_PART1(EA) asm volatile("s_waitcnt lgkmcnt(15)" : "+v"(LAB0), "+v"(LAB1), "+v"(LAR0), "+v"(LAR1)); SC_PART2(LA, 2, yk2) }
            { asm volatile("s_waitcnt lgkmcnt(11)" : "+v"(EBA0), "+v"(EBA1), "+v"(EBW0), "+v"(EBW1), "+v"(EBK0), "+v"(EBK1), "+v"(EBv)); DSR128(LAB0, qa, 21504); DSR128(LAB1, qa, 21520); DSR128(LAR0, qa, 37888); DSR128(LAR1, qa, 37904); DSR128(EAA0, qa, 13568); DSR128(EAA1, qa, 13584); DSR128(EAW0, qa, 5376); DSR128(EAW1, qa, 5392); DSR128(EAK0, qa, 29952); DSR128(EAK1, qa, 29968); DSR32(EAv, va, 5376); SC_PART1(EB) asm volatile("s_waitcnt lgkmcnt(15)" : "+v"(LBB0), "+v"(LBB1), "+v"(LBR0), "+v"(LBR1)); SC_PART2(LB, 3, yk2) }
            { asm volatile("s_waitcnt lgkmcnt(11)" : "+v"(ECA0), "+v"(ECA1), "+v"(ECW0), "+v"(ECW1), "+v"(ECK0), "+v"(ECK1), "+v"(ECv)); DSR128(LBB0, qa, 21760); DSR128(LBB1, qa, 21776); DSR128(LBR0, qa, 38144); DSR128(LBR1, qa, 38160); DSR128(EBA0, qa, 13824); DSR128(EBA1, qa, 13840); DSR128(EBW0, qa, 5632); DSR128(EBW1, qa, 5648); DSR128(EBK0, qa, 30208); DSR128(EBK1, qa, 30224); DSR32(EBv, va, 5632); SC_PART1(EC) asm volatile("s_waitcnt lgkmcnt(15)" : "+v"(LAB0), "+v"(LAB1), "+v"(LAR0), "+v"(LAR1)); SC_PART2(LA, 4, yk2) }
            { asm volatile("s_waitcnt lgkmcnt(11)" : "+v"(EAA0), "+v"(EAA1), "+v"(EAW0), "+v"(EAW1), "+v"(EAK0), "+v"(EAK1), "+v"(EAv)); DSR128(LAB0, qa, 22016); DSR128(LAB1, qa, 22032); DSR128(LAR0, qa, 38400); DSR128(LAR1, qa, 38416); DSR128(ECA0, qa, 14080); DSR128(ECA1, qa, 14096); DSR128(ECW0, qa, 5888); DSR128(ECW1, qa, 5904); DSR128(ECK0, qa, 30464); DSR128(ECK1, qa, 30480); DSR32(ECv, va, 5888); SC_PART1(EA) asm volatile("s_waitcnt lgkmcnt(15)" : "+v"(LBB0), "+v"(LBB1), "+v"(LBR0), "+v"(LBR1)); SC_PART2(LB, 5, yk2) }
            { asm volatile("s_waitcnt lgkmcnt(11)" : "+v"(EBA0), "+v"(EBA1), "+v"(EBW0), "+v"(EBW1), "+v"(EBK0), "+v"(EBK1), "+v"(EBv)); DSR128(LBB0, qa, 22272); DSR128(LBB1, qa, 22288); DSR128(LBR0, qa, 38656); DSR128(LBR1, qa, 38672); DSR128(EAA0, qa, 14336); DSR128(EAA1, qa, 14352); DSR128(EAW0, qa, 6144); DSR128(EAW1, qa, 6160); DSR128(EAK0, qa, 30720); DSR128(EAK1, qa, 30736); DSR32(EAv, va, 6144); SC_PART1(EB) asm volatile("s_waitcnt lgkmcnt(15)" : "+v"(LAB0), "+v"(LAB1), "+v"(LAR0), "+v"(LAR1)); SC_PART2(LA, 6, yk2) }
            { asm volatile("s_waitcnt lgkmcnt(11)" : "+v"(ECA0), "+v"(ECA1), "+v"(ECW0), "+v"(ECW1), "+v"(ECK0), "+v"(ECK1), "+v"(ECv)); DSR128(LAB0, qa, 22528); DSR128(LAB1, qa, 22544); DSR128(LAR0, qa, 38912); DSR128(LAR1, qa, 38928); DSR128(EBA0, qa, 14592); DSR128(EBA1, qa, 14608); DSR128(EBW0, qa, 6400); DSR128(EBW1, qa, 6416); DSR128(EBK0, qa, 30976); DSR128(EBK1, qa, 30992); DSR32(EBv, va, 6400); SC_PART1(EC) asm volatile("s_waitcnt lgkmcnt(15)" : "+v"(LBB0), "+v"(LBB1), "+v"(LBR0), "+v"(LBR1)); SC_PART2(LB, 7, yk2) }
            { asm volatile("s_waitcnt lgkmcnt(11)" : "+v"(EAA0), "+v"(EAA1), "+v"(EAW0), "+v"(EAW1), "+v"(EAK0), "+v"(EAK1), "+v"(EAv)); DSR128(LBB0, qa, 22784); DSR128(LBB1, qa, 22800); DSR128(LBR0, qa, 39168); DSR128(LBR1, qa, 39184); DSR128(ECA0, qa, 14848); DSR128(ECA1, qa, 14864); DSR128(ECW0, qa, 6656); DSR128(ECW1, qa, 6672); DSR128(ECK0, qa, 31232); DSR128(ECK1, qa, 31248); DSR32(ECv, va, 6656); SC_PART1(EA) asm volatile("s_waitcnt lgkmcnt(15)" : "+v"(LAB0), "+v"(LAB1), "+v"(LAR0), "+v"(LAR1)); SC_PART2(LA, 0, yk3) }
            { asm volatile("s_waitcnt lgkmcnt(11)" : "+v"(EBA0), "+v"(EBA1), "+v"(EBW0), "+v"(EBW1), "+v"(EBK0), "+v"(EBK1), "+v"(EBv)); DSR128(LAB0, qa, 23040); DSR128(LAB1, qa, 23056); DSR128(LAR0, qa, 39424); DSR128(LAR1, qa, 39440); DSR128(EAA0, qa, 15104); DSR128(EAA1, qa, 15120); DSR128(EAW0, qa, 6912); DSR128(EAW1, qa, 6928); DSR128(EAK0, qa, 31488); DSR128(EAK1, qa, 31504); DSR32(EAv, va, 6912); SC_PART1(EB) asm volatile("s_waitcnt lgkmcnt(15)" : "+v"(LBB0), "+v"(LBB1), "+v"(LBR0), "+v"(LBR1)); SC_PART2(LB, 1, yk3) }
            { asm volatile("s_waitcnt lgkmcnt(11)" : "+v"(ECA0), "+v"(ECA1), "+v"(ECW0), "+v"(ECW1), "+v"(ECK0), "+v"(ECK1), "+v"(ECv)); DSR128(LBB0, qa, 23296); DSR128(LBB1, qa, 23312); DSR128(LBR0, qa, 39680); DSR128(LBR1, qa, 39696); DSR128(EBA0, qa, 15360); DSR128(EBA1, qa, 15376); DSR128(EBW0, qa, 7168); DSR128(EBW1, qa, 7184); DSR128(EBK0, qa, 31744); DSR128(EBK1, qa, 31760); DSR32(EBv, va, 7168); SC_PART1(EC) asm volatile("s_waitcnt lgkmcnt(15)" : "+v"(LAB0), "+v"(LAB1), "+v"(LAR0), "+v"(LAR1)); SC_PART2(LA, 2, yk3) }
            { asm volatile("s_waitcnt lgkmcnt(11)" : "+v"(EAA0), "+v"(EAA1), "+v"(EAW0), "+v"(EAW1), "+v"(EAK0), "+v"(EAK1), "+v"(EAv)); DSR128(LAB0, qa, 23552); DSR128(LAB1, qa, 23568); DSR128(LAR0, qa, 39936); DSR128(LAR1, qa, 39952); DSR128(ECA0, qa, 15616); DSR128(ECA1, qa, 15632); DSR128(ECW0, qa, 7424); DSR128(ECW1, qa, 7440); DSR128(ECK0, qa, 32000); DSR128(ECK1, qa, 32016); DSR32(ECv, va, 7424); SC_PART1(EA) asm volatile("s_waitcnt lgkmcnt(15)" : "+v"(LBB0), "+v"(LBB1), "+v"(LBR0), "+v"(LBR1)); SC_PART2(LB, 3, yk3) }
            { asm volatile("s_waitcnt lgkmcnt(11)" : "+v"(EBA0), "+v"(EBA1), "+v"(EBW0), "+v"(EBW1), "+v"(EBK0), "+v"(EBK1), "+v"(EBv)); DSR128(LBB0, qa, 23808); DSR128(LBB1, qa, 23824); DSR128(LBR0, qa, 40192); DSR128(LBR1, qa, 40208); DSR128(EAA0, qa, 15872); DSR128(EAA1, qa, 15888); DSR128(EAW0, qa, 7680); DSR128(EAW1, qa, 7696); DSR128(EAK0, qa, 32256); DSR128(EAK1, qa, 32272); DSR32(EAv, va, 7680); SC_PART1(EB) asm volatile("s_waitcnt lgkmcnt(15)" : "+v"(LAB0), "+v"(LAB1), "+v"(LAR0), "+v"(LAR1)); SC_PART2(LA, 4, yk3) }
            { asm volatile("s_waitcnt lgkmcnt(11)" : "+v"(ECA0), "+v"(ECA1), "+v"(ECW0), "+v"(ECW1), "+v"(ECK0), "+v"(ECK1), "+v"(ECv)); DSR128(LAB0, qa, 24064); DSR128(LAB1, qa, 24080); DSR128(LAR0, qa, 40448); DSR128(LAR1, qa, 40464); DSR128(EBA0, qa, 16128); DSR128(EBA1, qa, 16144); DSR128(EBW0, qa, 7936); DSR128(EBW1, qa, 7952); DSR128(EBK0, qa, 32512); DSR128(EBK1, qa, 32528); DSR32(EBv, va, 7936); SC_PART1(EC) asm volatile("s_waitcnt lgkmcnt(15)" : "+v"(LBB0), "+v"(LBB1), "+v"(LBR0), "+v"(LBR1)); SC_PART2(LB, 5, yk3) }
            { asm volatile("s_waitcnt lgkmcnt(11)" : "+v"(EAA0), "+v"(EAA1), "+v"(EAW0), "+v"(EAW1), "+v"(EAK0), "+v"(EAK1), "+v"(EAv)); DSR128(LBB0, qa, 24320); DSR128(LBB1, qa, 24336); DSR128(LBR0, qa, 40704); DSR128(LBR1, qa, 40720); SC_PART1(EA) asm volatile("s_waitcnt lgkmcnt(11)" : "+v"(LAB0), "+v"(LAB1), "+v"(LAR0), "+v"(LAR1)); SC_PART2(LA, 6, yk3) }
            { asm volatile("s_waitcnt lgkmcnt(4)" : "+v"(EBA0), "+v"(EBA1), "+v"(EBW0), "+v"(EBW1), "+v"(EBK0), "+v"(EBK1), "+v"(EBv)); SC_PART1(EB) asm volatile("s_waitcnt lgkmcnt(0)" : "+v"(LBB0), "+v"(LBB1), "+v"(LBR0), "+v"(LBR1)); SC_PART2(LB, 7, yk3) }
            yb[jq * 32 + rloc] = yk0; yb[(jq + 8) * 32 + rloc] = yk1; yb[(jq + 16) * 32 + rloc] = yk2; yb[(jq + 24) * 32 + rloc] = yk3;
            __syncthreads();
        }
#undef DSR128
#undef DSR32
#undef SC_PART1
#undef SC_PART2
    }
}
__device__ __forceinline__ void post_phase(bf16_t* Y, bf16_t* Yo, const bf16_t* __restrict__ V, int ldv, const bf16_t* __restrict__ GT, const float* __restrict__ CB, const float* gn_w, const float* gn_b, int ghw, int NHW, int tid) {
    const int jp = tid & 31, h = ghw & 7, col = h * 64 + 2 * jp;
    const float gw0 = gn_w[col], gw1 = gn_w[col + 1], gb0 = gn_b[col], gb1 = gn_b[col + 1];
    for (int g0 = ghw; g0 < M * 8; g0 += 8 * NHW) {
        unsigned yw[8], vw[8], gg[8]; float bon[8];
#pragma unroll
        for (int u = 0; u < 8; ++u) { const int g = g0 + u * NHW; const size_t m = (size_t)(g >> 3);
            yw[u] = *(const unsigned*)(Y + m * 512 + col); vw[u] = *(const unsigned*)(V + m * (size_t)ldv + col); gg[u] = *(const unsigned*)(GT + m * 512 + col); bon[u] = CB[g]; }
#pragma unroll
        for (int u = 0; u < 8; ++u) { const int g = g0 + u * NHW; const size_t m = (size_t)(g >> 3);
            const float y0 = bflo(yw[u]), y1 = bfhi(yw[u]);
            const float mean = half_sum(y0 + y1) * (1.f / 64.f);
            const float d0 = y0 - mean, d1 = y1 - mean;
            const float var = half_sum(d0 * d0 + d1 * d1) * (1.f / 64.f);
            const float rs = rsqrtf(var + 64e-5f);
            const float o0 = (d0 * rs * gw0 + gb0 + bon[u] * bflo(vw[u])) * bflo(gg[u]), o1 = (d1 * rs * gw1 + gb1 + bon[u] * bfhi(vw[u])) * bfhi(gg[u]);
            *(unsigned*)(Yo + m * 1024 + col) = pk2(o0, o1); }
    }
}

#define XB_TMO      128
#define XB_XCNT(j)  (256  + 64 * (j))
#define XB_XSUB(j)  (1280 + 64 * (j))
#define XB_XGEN(j)  (2304 + 64 * (j))
#define XB_TOP      3328
#define XB_TOPGEN   3392
#define XCD_BAR_WORDS 3456
#define XB_SPIN_CAP (1u << 18)

__device__ __forceinline__ unsigned xb_ld(unsigned* p)              { return __hip_atomic_load(p, __ATOMIC_RELAXED, __HIP_MEMORY_SCOPE_AGENT); }
__device__ __forceinline__ unsigned xb_add(unsigned* p, unsigned v) { return __hip_atomic_fetch_add(p, v, __ATOMIC_RELAXED, __HIP_MEMORY_SCOPE_AGENT); }
__device__ __forceinline__ unsigned xb_xcc_id() { return (unsigned)__builtin_amdgcn_s_getreg((3 << 11) | 20) & 0xFu; }
#define XB_SPIN(cond, bar) do { unsigned _sp = 0; while (cond) { __builtin_amdgcn_s_sleep(1); \
    if ((++_sp & 255u) == 0u) { if (xb_ld(&(bar)[XB_TMO])) break; if (_sp > XB_SPIN_CAP) { atomicAdd(&(bar)[XB_TMO], 1u); break; } } } } while (0)

struct XcdBarrier {
    unsigned* bar; unsigned x;
    volatile LAS unsigned* st;
};

__device__ __forceinline__ XcdBarrier xcd_barrier_post(unsigned* bar, volatile LAS unsigned* st) {
    XcdBarrier b; b.bar = bar; b.x = xb_xcc_id(); b.st = st;
    if (threadIdx.x == 0) (void)xb_add(&bar[XB_XCNT(b.x)], 1u);
    return b;
}
__device__ __forceinline__ void xcd_barrier_complete(unsigned* bar, unsigned x, unsigned& nloc, unsigned& nx) {
    const unsigned G = gridDim.x * gridDim.y * gridDim.z;
    unsigned sum, cnt, mine, sp = 0u;
    for (;;) {
        sum = 0u; cnt = 0u; mine = 0u;
#pragma unroll
        for (unsigned j = 0; j < 16; ++j) { const unsigned c = xb_ld(&bar[XB_XCNT(j)]); sum += c; cnt += (c > 0u) ? 1u : 0u; mine = (j == x) ? c : mine; }
        if (sum == G) break;
        __builtin_amdgcn_s_sleep(1);
        if ((++sp & 255u) == 0u) { if (xb_ld(&bar[XB_TMO])) break; if (sp > XB_SPIN_CAP) { atomicAdd(&bar[XB_TMO], 1u); break; } }
    }
    nloc = mine > 0u ? mine : 1u; nx = cnt > 0u ? cnt : 1u;
}

__device__ __forceinline__ void xcd_barrier(const XcdBarrier& b) {
    asm volatile("s_waitcnt vmcnt(0)" ::: "memory");
    __syncthreads();
    if (threadIdx.x == 0) {
        unsigned* bar = b.bar;
        __builtin_amdgcn_s_waitcnt(0);
        unsigned nloc = b.st[0], nx = b.st[1];
        if (nloc == 0u) { xcd_barrier_complete(bar, b.x, nloc, nx); b.st[0] = nloc; b.st[1] = nx; }
        const unsigned old = xb_add(&bar[XB_XSUB(b.x)], 1u);
        const unsigned gen = old / nloc;
        if (old + 1u == (gen + 1u) * nloc) {
            __builtin_amdgcn_fence(__ATOMIC_RELEASE, "agent");
            asm volatile("s_waitcnt vmcnt(0)" ::: "memory");
            const unsigned og = xb_add(&bar[XB_TOP], 1u);
            const unsigned tg = og / nx;
            if (og + 1u == (tg + 1u) * nx) xb_add(&bar[XB_TOPGEN], 1u);
            else XB_SPIN(xb_ld(&bar[XB_TOPGEN]) == tg, bar);
            __builtin_amdgcn_fence(__ATOMIC_ACQUIRE, "agent");
            xb_add(&bar[XB_XGEN(b.x)], 1u);
            asm volatile("s_waitcnt vmcnt(0)" ::: "memory");
        } else {
            XB_SPIN(xb_ld(&bar[XB_XGEN(b.x)]) == gen, bar);
            __builtin_amdgcn_fence(__ATOMIC_ACQUIRE, "agent");
            asm volatile("s_waitcnt vmcnt(0)" ::: "memory");
        }
    }
    __syncthreads();
}


#ifndef PHM
#define PHM 0xFFFF
#endif
#define PH(k) ((PHM >> (k)) & 1)
#ifndef DUPM
#define DUPM 0
#endif
#define DUP(k) ((DUPM >> (k)) & 1)
#define REP(k) for (int rep_ = 0; rep_ < PH(k) + DUP(k); ++rep_)
#define WSP(T, off) ((T*)(T GAS*)(q->ws + (off)))
__global__ void __launch_bounds__(512, 2) mega_fwd(Params p_unused) {
    extern __shared__ __attribute__((aligned(16))) unsigned char lds_raw[];
    LAS unsigned char* lds = (LAS unsigned char*)lds_raw;
    cg::grid_group grid = cg::this_grid();
    const int G = gridDim.x, NGW = G * 8, NT = G * 512;
    volatile LAS unsigned* bst = (volatile LAS unsigned*)(lds + 131072);
    if (threadIdx.x < 2) bst[threadIdx.x] = 0u;
    __syncthreads();
    const XcdBarrier xbar = xcd_barrier_post((unsigned*)(((const Params*)__builtin_amdgcn_kernarg_segment_ptr())->ws + WS_BAR), bst);
#define GSYNC() xcd_barrier(xbar)

    REP(0) { const Params* q = opaque_params(); const int t_ = opaque_tid(); prologue(*q, lds, t_, t_ & 63, __builtin_amdgcn_readfirstlane(t_ >> 6), opaque_bid(), G); }
    grid.sync();

#pragma unroll 1
    for (int l = 0; l < NL; ++l) {
        REP(1) { const Params* q = opaque_params(); const int t_ = opaque_tid();
            norm_phase(l == 0 ? GP(q->x) : ((float*)(q->out)), GP(q->norm1_g) + l * DM, WSP(const float, WS_MOD) + (size_t)l * NB * NMOD, 0, WSP(bf16_t, WS_H), opaque_bid() * 8 + (t_ >> 6), NGW, t_ & 63); }
        GSYNC();
        REP(2) { const Params* q = opaque_params(); const bf16_t* Wl = WSP(const bf16_t, 0) + (size_t)l * LW;
            pg8::Gemm g{WSP(bf16_t, WS_H), Wl + O_IN, DM, DM, M, INC, DM}; pg8::StaticOrder S; S.init(M, INC, G, opaque_bid());
            pg8::EpiInproj E{WSP(bf16_t, WS_PRW), WSP(bf16_t, WS_PGM), WSP(bf16_t, WS_G)};
            pg8::gemm_phase<pg8::EpiInproj, true>(lds, g, S, E); }
        GSYNC();
        if (PH(3)) { const Params* q = opaque_params(); const int t_ = opaque_tid(); const bf16_t* Wl = WSP(const bf16_t, 0) + (size_t)l * LW;
            for (int it = opaque_bid(); it < M / 128; it += G)
                gmlp_item(lds, WSP(bf16_t, WS_PGM), WSP(bf16_t, WS_PGM), Wl + O_WS, GP(q->ln_w) + l * 512, GP(q->ln_b) + l * 512, GP(q->b_sp) + l * 512, it, t_, t_ & 63, __builtin_amdgcn_readfirstlane(t_ >> 6)); }
        REP(4) { const Params* q = opaque_params();
            prep1_phase(WSP(bf16_t, WS_PRW), GP(q->mu_shift) + l * RWC, WSP(bf16_t, WS_R), WSP(bf16_t, WS_K0), l == 0 ? WSP(bf16_t, WS_VF) : WSP(bf16_t, WS_V0), WSP(bf16_t, WS_LIN), opaque_bid() * 512 + opaque_tid(), NT); }
        GSYNC();
        REP(5) { const Params* q = opaque_params(); const bf16_t* Wl = WSP(const bf16_t, 0) + (size_t)l * LW;
            pg8::Gemm g{WSP(bf16_t, WS_LIN), Wl + O_LORA, 256, 256, M, 1536, 256}; pg8::StaticOrder S; S.init(M, 1536, G, opaque_bid());
            pg8::EpiLora E{WSP(bf16_t, WS_OMD), GP(q->w0_decay) + l * 512, GP(q->a0) + l * 512};
            pg8::gemm_phase<pg8::EpiLora, true>(lds, g, S, E); }
        if (l > 0) REP(6) { const Params* q = opaque_params(); const bf16_t* Wl = WSP(const bf16_t, 0) + (size_t)l * LW;
            pg8::Gemm g{WSP(bf16_t, WS_V0), Wl + O_V12, 512, 512, M, 512, 512}; pg8::StaticOrder S; S.init(M, 512, G, opaque_bid());
            pg8::EpiVres E{WSP(bf16_t, WS_V0), WSP(bf16_t, WS_VF), WSP(bf16_t, WS_PGM) + 512, 1024, GP(q->v0_res) + (l - 1) * 512};
            pg8::gemm_phase<pg8::EpiVres, true>(lds, g, S, E); }
        GSYNC();
        REP(7) { const Params* q = opaque_params();
            scan_phase(lds, WSP(bf16_t, WS_R), WSP(bf16_t, WS_K0), WSP(bf16_t, WS_ASIG), WSP(bf16_t, WS_OMD), l == 0 ? WSP(bf16_t, WS_VF) : WSP(bf16_t, WS_PGM) + 512, l == 0 ? 512 : 1024,
                       WSP(bf16_t, WS_YRW), WSP(float, WS_CB), GP(q->k_k) + l * 512, GP(q->k_a) + l * 512, GP(q->r_k) + l * 512, GP(q->w0_decay) + l * 512, GP(q->a0) + l * 512, opaque_bid(), opaque_tid()); }
        GSYNC();
        REP(13) { const Params* q = opaque_params(); const int t_ = opaque_tid();
            post_phase(WSP(bf16_t, WS_YRW), WSP(bf16_t, WS_PGM) + 512, l == 0 ? WSP(bf16_t, WS_VF) : WSP(bf16_t, WS_PGM) + 512, l == 0 ? 512 : 1024, WSP(bf16_t, WS_GT), WSP(const float, WS_CB),
                       GP(q->gn_w) + l * 512, GP(q->gn_b) + l * 512, opaque_bid() * 16 + (t_ >> 5), G * 16, t_); }
        GSYNC();
        REP(8) { const Params* q = opaque_params(); const bf16_t* Wl = WSP(const bf16_t, 0) + (size_t)l * LW;
            pg8::StaticOrder S; S.init(M, DM, G, opaque_bid());
            pg8::Gemm g1{WSP(bf16_t, WS_PGM), Wl + O_BR1, 1024, 1024, M, DM, 1024}; pg8::EpiMergeF E1{WSP(bf16_t, WS_G), WSP(bf16_t, WS_MG)};
            pg8::gemm_phase<pg8::EpiMergeF, true, true>(lds, g1, S, E1); }
        GSYNC();
        REP(9) { const Params* q = opaque_params(); const bf16_t* Wl = WSP(const bf16_t, 0) + (size_t)l * LW;
            pg8::Gemm g{WSP(bf16_t, WS_MG), Wl + O_OUT, DM, DM, M, DM, DM}; pg8::StaticOrder S; S.init(M, DM, G, opaque_bid());
            pg8::EpiResid E{l == 0 ? GP(q->x) : ((float*)(q->out)), ((float*)(q->out)), WSP(const float, WS_MOD) + (size_t)l * NB * NMOD + 2 * DM};
            pg8::gemm_phase<pg8::EpiResid, true>(lds, g, S, E); }
        GSYNC();
        REP(10) { const Params* q = opaque_params(); const int t_ = opaque_tid();
            norm_phase(((float*)(q->out)), GP(q->norm2_g) + l * DM, WSP(const float, WS_MOD) + (size_t)l * NB * NMOD, 3 * DM, WSP(bf16_t, WS_H), opaque_bid() * 8 + (t_ >> 6), NGW, t_ & 63); }
        GSYNC();
        REP(11) { const Params* q = opaque_params(); const bf16_t* Wl = WSP(const bf16_t, 0) + (size_t)l * LW;
            pg8::Gemm g{WSP(bf16_t, WS_H), Wl + O_FF1, DM, DM, M, DFF, DM}; pg8::StaticOrder S; S.init(M, DFF, G, opaque_bid());
            pg8::EpiFF1 E{WSP(bf16_t, WS_FH)};
            pg8::gemm_phase<pg8::EpiFF1, true>(lds, g, S, E); }
        GSYNC();
        REP(12) { const Params* q = opaque_params(); const bf16_t* Wl = WSP(const bf16_t, 0) + (size_t)l * LW;
            pg8::Gemm g{WSP(bf16_t, WS_FH), Wl + O_FF2, DFF, DFF, M, DM, DFF}; pg8::StaticOrder S; S.init(M, DM, G, opaque_bid());
            pg8::EpiResid E{((float*)(q->out)), ((float*)(q->out)), WSP(const float, WS_MOD) + (size_t)l * NB * NMOD + 5 * DM};
            pg8::gemm_phase<pg8::EpiResid, true>(lds, g, S, E); }
        GSYNC();
    }
    { const Params* q = opaque_params(); const int t_ = opaque_tid(); final_norm(((float*)(q->out)), GP(q->final_g), opaque_bid() * 8 + (t_ >> 6), NGW, t_ & 63); }
}

extern "C" void kernel_launch(void* const* d_in, const int* in_sizes, int n_in, void* d_out, int out_size, void* d_ws, size_t ws_size, hipStream_t stream) {
    static int grid = 0;
    if (grid == 0) {
        if (n_in != 31 || ws_size < WS_END) { fprintf(stderr, "kernel_launch: unexpected n_in %d / ws_size %zu\n", n_in, ws_size); grid = -1; return; }
        int dev = 0, cus = 0, per_cu = 0;
        hipGetDevice(&dev);
        hipDeviceGetAttribute(&cus, hipDeviceAttributeMultiprocessorCount, dev);
        hipFuncSetAttribute((const void*)mega_fwd, hipFuncAttributeMaxDynamicSharedMemorySize, LDS_BYTES);
        hipOccupancyMaxActiveBlocksPerMultiprocessor(&per_cu, (const void*)mega_fwd, 512, LDS_BYTES);
        if (per_cu < 1) { fprintf(stderr, "kernel_launch: occupancy query says %d blocks/CU\n", per_cu); per_cu = 1; }
        if (cus != 256) { fprintf(stderr, "kernel_launch: built for 256 CUs, found %d\n", cus); grid = -1; return; }
        grid = cus;
        (void)hipGetLastError();
    }
    if (grid < 0) return;
    Params p{};
    const float** pp = (const float**)&p;
    for (int i = 0; i < 31; ++i) pp[i] = (const float*)d_in[i];
    p.out = (float GAS*)d_out; p.ws = (unsigned char GAS*)d_ws;
    if (hipMemsetAsync((char*)d_ws + WS_BAR, 0, WS_BAR_BYTES, stream) != hipSuccess) { fprintf(stderr, "kernel_launch: memset of the barrier words failed\n"); return; }
    void* args[] = {&p};
    hipError_t e = hipLaunchCooperativeKernel((const void*)mega_fwd, dim3(grid), dim3(512), args, LDS_BYTES, stream);
    if (e != hipSuccess) fprintf(stderr, "cooperative launch failed: %s (grid %d)\n", hipGetErrorString(e), grid);
}
```

```cpp
#include <hip/hip_runtime.h>
#include <hip/hip_cooperative_groups.h>
#include <cstdio>
#include <cstdint>
namespace cg = cooperative_groups;

#define LAS __attribute__((address_space(3)))
typedef unsigned short bf16_t;
typedef short bf16x8 __attribute__((ext_vector_type(8)));
typedef float f32x4 __attribute__((ext_vector_type(4)));
typedef float f32x2 __attribute__((ext_vector_type(2)));
typedef unsigned u32x4 __attribute__((ext_vector_type(4)));
typedef unsigned u32x2 __attribute__((ext_vector_type(2)));

constexpr int NB = 16, SEQ = 4096, DM = 1024, M = NB * SEQ, NL = 4;
constexpr int RW = 512, INC = 4864, RWC = 1792, DFF = 4096, NMOD = 6 * DM;
constexpr size_t U = 64ull << 20;
constexpr size_t O_IN = 0, O_LORA = O_IN + 4864ull * 1024, O_V12 = O_LORA + 1536ull * 256, O_WS = O_V12 + 512ull * 512,
                 O_BR1 = O_WS + 4ull * 128 * 128, O_BR2 = O_BR1 + 1024ull * 512, O_OUT = O_BR2 + 1024ull * 512,
                 O_FF1 = O_OUT + 1024ull * 1024, O_FF2 = O_FF1 + 4096ull * 1024, LW = O_FF2 + 1024ull * 4096;
constexpr size_t WS_BAR = (125ull << 20) + (512ull << 10), WS_BAR_BYTES = 16384;
constexpr size_t WS_MOD = 124ull << 20, WS_CB = 126ull << 20;
static_assert(LW * 2 * NL <= WS_MOD, "weights fit");
constexpr size_t WS_VF = 2 * U, WS_G = 3 * U, WS_PGM = 7 * U, WS_PRW = 9 * U, WS_LIN = 12 * U + U / 2, WS_R = 13 * U, WS_K0 = 14 * U,
                 WS_V0 = 15 * U, WS_YRW = 15 * U, WS_OMD = 9 * U, WS_ASIG = 10 * U, WS_GT = 11 * U, WS_MGF = 9 * U, WS_MG = 13 * U,
                 WS_H = 13 * U, WS_FH = 3 * U, WS_END = 16 * U;
static_assert(WS_ASIG == WS_OMD + U && WS_GT == WS_OMD + 2 * U, "EpiLora output spacing");
constexpr int LDS_BYTES = 135168;

#define GAS __attribute__((address_space(1)))
typedef const float GAS* gcf_t;
struct Params {
    gcf_t x, c, w_ada, b_ada, norm1_g, norm2_g, w_in, mu_shift, w0_decay, w2_decay, a0, w2_aaa, w2_gate, k_k, k_a, r_k,
        gn_w, gn_b, v0_res, w1_res, w2_res, ln_w, ln_b, w_sp, b_sp, w_br_rw, w_br_gm, w_out, w_ff1, w_ff2, final_g;
    float GAS* out; unsigned char GAS* ws;
};

#define GP(ptr_) ((const float*)(ptr_))
__device__ __forceinline__ float bflo(unsigned w) { return __builtin_bit_cast(float, w << 16); }
__device__ __forceinline__ float bfhi(unsigned w) { return __builtin_bit_cast(float, w & 0xffff0000u); }
__device__ __forceinline__ float bf1(bf16_t v) { return __builtin_bit_cast(float, (unsigned)v << 16); }
__device__ __forceinline__ unsigned f2bf(float f) { unsigned u = __builtin_bit_cast(unsigned, f); return (u + 0x7fffu + ((u >> 16) & 1u)) >> 16; }
typedef __bf16 bf16x2_t __attribute__((ext_vector_type(2)));
__device__ __forceinline__ unsigned pk2(float lo, float hi) { const f32x2 v = {lo, hi}; const bf16x2_t b = __builtin_convertvector(v, bf16x2_t); return __builtin_bit_cast(unsigned, b); }
__device__ __forceinline__ float rcpf_(float x) { return __builtin_amdgcn_rcpf(x); }
__device__ __forceinline__ float sigmoidf_(float x) { return rcpf_(1.f + __expf(-x)); }
__device__ __forceinline__ float tanhf_(float x) { return 1.f - 2.f * rcpf_(__expf(2.f * x) + 1.f); }
#define DPP_ADD(x, ctrl) ((x) + __builtin_bit_cast(float, __builtin_amdgcn_update_dpp(0, __builtin_bit_cast(int, (x)), (ctrl), 0xF, 0xF, true)))
__device__ __forceinline__ float red8(float x) { x = DPP_ADD(x, 0xB1); x = DPP_ADD(x, 0x4E); x = DPP_ADD(x, 0x141); return x; }
__device__ __forceinline__ float row_sum16(float x) { x = red8(x); x = DPP_ADD(x, 0x140); return x; }
__device__ __forceinline__ float half_sum(float v) {
    v = row_sum16(v);
    return v + __builtin_bit_cast(float, __builtin_amdgcn_ds_swizzle(__builtin_bit_cast(int, v), 0x401F));
}
__device__ __forceinline__ float wave_sum(float v) {
    v = half_sum(v);
    return __builtin_bit_cast(float, __builtin_amdgcn_readlane(__builtin_bit_cast(int, v), 0)) + __builtin_bit_cast(float, __builtin_amdgcn_readlane(__builtin_bit_cast(int, v), 32));
}
__device__ __forceinline__ int opaque_tid() { int t = threadIdx.x; asm volatile("" : "+v"(t)); return t; }
__device__ __forceinline__ const struct Params* opaque_params() { const struct Params* q = (const struct Params*)__builtin_amdgcn_kernarg_segment_ptr(); asm volatile("" : "+s"(q)); return q; }
__device__ __forceinline__ int opaque_bid() { int b = blockIdx.x; asm volatile("" : "+s"(b)); return b; }
__device__ __forceinline__ float omd_of(float d) {
    const float x = -d, sp = fmaxf(x, 0.f) + 0.69314718f * __builtin_amdgcn_logf(1.f + __builtin_amdgcn_exp2f(-1.44269504f * fabsf(x)));
    const float e = __builtin_amdgcn_exp2f((-sp - 0.5f) * 1.44269504f);
    const float poly = e * (1.f - e * (0.5f - e * (0.16666667f - e * (0.041666668f - e * 0.0083333333f))));
    const float big = 1.f - __builtin_amdgcn_exp2f(-1.44269504f * e);
    return e < 0.125f ? poly : big;
}
__device__ __forceinline__ float decay_of(float d) {
    const float sg = rcpf_(1.f + __builtin_amdgcn_exp2f(-1.44269504f * d));
    return __builtin_amdgcn_exp2f(-0.87503877f * sg);
}
__device__ __forceinline__ float gelu1(float v) {
    const float av = fabsf(v), t = rcpf_(av * 0.2316418882f + 1.0f);
    float q = t * 0.5307027145f + (-0.7265760135f); q = q * t + 0.7107068705f; q = q * t + (-0.142248368f); q = q * t + 0.127414796f; q = q * t;
    const float e = __builtin_amdgcn_exp2f((v * v) * (-0.72134752044f));
    const float m = v * (q * e);
    return v < 0.f ? m : v - m;
}

namespace pg8 {
constexpr int BM = 256, BK = 64, HALF = 128, HTB = HALF * BK * 2, STAGE_BYTES = 8 * HTB, NXCD = 8, WGM = 8;
__host__ __device__ __forceinline__ int lds_byte(int r, int c) { const int st = (r >> 4) * 2 + (c >> 5), rr = r & 15, cc = c & 31, ob = rr * 64 + cc * 2; return st * 1024 + (ob ^ (((ob >> 9) & 1) << 5)); }
__host__ __device__ __forceinline__ void stage_rc(int b, int& R, int& C) { const int st = b / 1024, sb = b % 1024, swz = sb ^ (((sb >> 9) & 1) << 5); R = (st >> 1) * 16 + swz / 64; C = (st & 1) * 32 + (swz % 64) / 2; }
__host__ __device__ __forceinline__ int perm32(int rho) { const int n = rho >> 4, i = rho & 15; return 8 * (i >> 2) + 4 * n + (i & 3); }

struct Unit { int pm, pn; };
__device__ __forceinline__ const char* uni(const char* p) { unsigned lo = __builtin_amdgcn_readfirstlane((unsigned)(size_t)p), hi = __builtin_amdgcn_readfirstlane((unsigned)((size_t)p >> 32));
    asm volatile("s_nop 4" : "+s"(lo), "+s"(hi));
    return (const char*)(((size_t)hi << 32) | (size_t)lo); }
struct Gemm { const bf16_t* A; const bf16_t* Bt; int lda, ldb, M, N, K; };

struct StaticOrder {
    int nM, nN, nwg, G, c;
    __device__ void init(int M_, int N_, int G_, int c_) { nM = M_ / BM; nN = N_ / BM; nwg = nM * nN; G = G_; c = c_; }
    __device__ bool next(int i, Unit& u) const {
        const long Lx = (long)i * G + c; if (Lx >= nwg) return false;
        int wgid = (int)Lx; { const int q = nwg / NXCD, r = nwg % NXCD, xcd = wgid % NXCD, off = wgid / NXCD; wgid = (xcd < r ? xcd * (q + 1) : r * (q + 1) + (xcd - r) * q) + off; }
        const int nig = WGM * nN, gid = wgid / nig, fm = gid * WGM, gsz = (nM - fm) < WGM ? (nM - fm) : WGM;
        u.pm = fm + ((wgid % nig) % gsz); u.pn = (wgid % nig) / gsz; return true;
    }
};

template <class Epi, bool ALIGN_EPI, bool MID = false>
__device__ __forceinline__ void gemm_phase(LAS unsigned char* lds, const Gemm g, const StaticOrder& S, const Epi& E) {
    const int tid = opaque_tid(), wid = __builtin_amdgcn_readfirstlane(tid >> 6), lane = tid & 63, wr = wid >> 2, wc = wid & 3, fr = lane & 15, fq = lane >> 4;
    const int K = g.K, nt = K / BK;
    unsigned voffA, voffB;
    { int R, C; stage_rc(tid * 16, R, C); const int Rb = (R & ~31) + perm32(R & 31);
      voffA = (unsigned)(R * g.lda + C) * 2u; voffB = (unsigned)(Rb * g.ldb + C) * 2u; }
    const size_t kstep = (size_t)(BK * 2);
    const size_t hstepA = (size_t)HALF * g.lda * 2, hstepB = (size_t)HALF * g.ldb * 2;
    const size_t tstepA = 2 * hstepA, tstepB = 2 * hstepB;
    const size_t pstepA = hstepA >> 1, pstepB = hstepB >> 1;
    const unsigned ldsbase = (unsigned)(size_t)lds + (unsigned)wid * 1024u;
    const int aoff = lds_byte(wr * 64 + fr, fq * 8), boff = lds_byte(wc * 32 + fr, fq * 8);
#define PG8_SA(b, h) (((b) * 2 + (h)) * HTB)
#define PG8_SB(b, h) ((4 + (b) * 2 + (h)) * HTB)
#define PG8_STAGE_(bufoff, gbase, voff, pstep) do { const char* _g0 = (const char*)(gbase); const char* _g1 = _g0 + (pstep); const unsigned _l0 = ldsbase + (unsigned)(bufoff), _l1 = _l0 + 8192u; \
        asm volatile("s_mov_b32 m0, %2\n\ts_nop 0\n\tglobal_load_lds_dwordx4 %0, %1" :: "v"(voff), "s"(_g0), "s"(_l0) : "memory"); \
        asm volatile("s_mov_b32 m0, %2\n\ts_nop 0\n\tglobal_load_lds_dwordx4 %0, %1" :: "v"(voff), "s"(_g1), "s"(_l1) : "memory"); } while (0)
#define PG8_STAGE(bufoff, gbase, voff) PG8_STAGE_(bufoff, gbase, voff, (&(voff) == &voffA) ? pstepA : pstepB)
#define PG8_LDA(dst, b, h) do { _Pragma("unroll") for (int m = 0; m < 4; ++m) _Pragma("unroll") for (int k = 0; k < 2; ++k) dst[m][k] = *(const LAS bf16x8*)(lds + PG8_SA(b, h) + aoff + m * 2048 + k * 1024); } while (0)
#define PG8_LDB(dst, b, h) do { _Pragma("unroll") for (int n = 0; n < 2; ++n) _Pragma("unroll") for (int k = 0; k < 2; ++k) dst[n][k] = *(const LAS bf16x8*)(lds + PG8_SB(b, h) + boff + n * 2048 + k * 1024); } while (0)
#define PG8_MMA(ai, bj, At, Bt) do { __builtin_amdgcn_s_setprio(1); _Pragma("unroll") for (int m = 0; m < 4; ++m) _Pragma("unroll") for (int n = 0; n < 2; ++n) _Pragma("unroll") for (int k = 0; k < 2; ++k) \
        acc[ai][bj][m][n] = __builtin_amdgcn_mfma_f32_16x16x32_bf16(Bt[n][k], At[m][k], acc[ai][bj][m][n], 0, 0, 0); __builtin_amdgcn_s_setprio(0); } while (0)
#define PG8_WAIT_V(n) asm volatile("s_waitcnt vmcnt(" #n ")" ::: "memory")
#define PG8_WAIT_L(n) asm volatile("s_waitcnt lgkmcnt(" #n ")" ::: "memory")
#define PG8_BAR __builtin_amdgcn_s_barrier()
#define PG8_SCHED __builtin_amdgcn_sched_barrier(0)
    Unit cur, nxt; int ui = 0;
    if (!S.next(0, cur)) return;
    f32x4 acc[2][2][4][2];
#pragma unroll
    for (int a = 0; a < 2; ++a)
#pragma unroll
        for (int b = 0; b < 2; ++b)
#pragma unroll
            for (int m = 0; m < 4; ++m)
#pragma unroll
                for (int n = 0; n < 2; ++n) acc[a][b][m][n] = (f32x4){0.f, 0.f, 0.f, 0.f};
    bf16x8 At[4][2], B0[2][2], B1[2][2];
    const char* cA = uni((const char*)g.A + (size_t)cur.pm * tstepA); const char* cB = uni((const char*)g.Bt + (size_t)cur.pn * tstepB);
    PG8_STAGE(PG8_SB(0, 0), cB, voffB); PG8_STAGE(PG8_SB(0, 1), cB + hstepB, voffB); PG8_STAGE(PG8_SA(0, 0), cA, voffA); PG8_STAGE(PG8_SA(0, 1), cA + hstepA, voffA);
    if (wr == 1) PG8_BAR;
    PG8_WAIT_V(2); PG8_BAR;
    PG8_STAGE(PG8_SB(1, 0), cB + kstep, voffB); PG8_STAGE(PG8_SA(1, 0), cA + kstep, voffA); PG8_STAGE(PG8_SB(1, 1), cB + hstepB + kstep, voffB);
    PG8_WAIT_V(6); PG8_BAR;
    for (;;) {
        const bool has_next = S.next(ui + 1, nxt);
        const char* nA = uni(has_next ? (const char*)g.A + (size_t)nxt.pm * tstepA : cA); const char* nB = uni(has_next ? (const char*)g.Bt + (size_t)nxt.pn * tstepB : cB);
#pragma unroll 1
        for (int t = 0; t < nt; t += 2) {
            const bool last = (t == nt - 2);
            if constexpr (MID) { if (t == (nt >> 1)) E.mid(acc, cur, wr, wc, fr, fq); }
            const char* a1 = cA + (size_t)(t + 1) * kstep;
            const char* a2 = last ? nA : cA + (size_t)(t + 2) * kstep; const char* b2 = last ? nB : cB + (size_t)(t + 2) * kstep;
            const char* a3 = a2 + kstep; const char* b3 = b2 + kstep;
            PG8_LDB(B0, 0, 0); PG8_LDB(B1, 0, 1); PG8_SCHED; PG8_LDA(At, 0, 0); PG8_STAGE(PG8_SA(1, 1), a1 + hstepA, voffA);
            PG8_WAIT_V(8); PG8_WAIT_L(0); PG8_BAR; PG8_MMA(0, 0, At, B0); PG8_MMA(0, 1, At, B1); PG8_BAR; PG8_SCHED;
            PG8_LDA(At, 0, 1); PG8_STAGE(PG8_SB(0, 0), b2, voffB); PG8_STAGE(PG8_SB(0, 1), b2 + hstepB, voffB); PG8_STAGE(PG8_SA(0, 0), a2, voffA);
            PG8_WAIT_V(8); PG8_WAIT_L(0); PG8_BAR; PG8_MMA(1, 0, At, B0); PG8_MMA(1, 1, At, B1); PG8_BAR; PG8_SCHED;
            PG8_LDB(B0, 1, 0); PG8_LDB(B1, 1, 1); PG8_SCHED; PG8_LDA(At, 1, 0); PG8_STAGE(PG8_SA(0, 1), a2 + hstepA, voffA);
            PG8_WAIT_V(8); PG8_WAIT_L(0); PG8_BAR; PG8_MMA(0, 0, At, B0); PG8_MMA(0, 1, At, B1); PG8_BAR; PG8_SCHED;
            PG8_LDA(At, 1, 1); PG8_STAGE(PG8_SB(1, 0), b3, voffB); PG8_STAGE(PG8_SB(1, 1), b3 + hstepB, voffB); PG8_STAGE(PG8_SA(1, 0), a3, voffA);
            PG8_WAIT_V(8); PG8_WAIT_L(0); PG8_BAR; PG8_MMA(1, 0, At, B0); PG8_MMA(1, 1, At, B1); PG8_BAR; PG8_SCHED;
        }
        if constexpr (ALIGN_EPI) { if (wr == 0) PG8_BAR; }
        E(acc, cur, wr, wc, fr, fq);
        if (!has_next) break;
#pragma unroll
        for (int a = 0; a < 2; ++a)
#pragma unroll
            for (int b = 0; b < 2; ++b)
#pragma unroll
                for (int m = 0; m < 4; ++m)
#pragma unroll
                    for (int n = 0; n < 2; ++n) acc[a][b][m][n] = (f32x4){0.f, 0.f, 0.f, 0.f};
        cur = nxt; cA = nA; cB = nB; ++ui;
        if constexpr (ALIGN_EPI) { if (wr == 1) PG8_BAR; }
    }
    PG8_WAIT_V(0);
    if constexpr (!ALIGN_EPI) { if (wr == 0) PG8_BAR; }
    PG8_BAR;
#undef PG8_SA
#undef PG8_SB
#undef PG8_STAGE
#undef PG8_STAGE_
#undef PG8_LDA
#undef PG8_LDB
#undef PG8_MMA
#undef PG8_WAIT_V
#undef PG8_WAIT_L
#undef PG8_BAR
#undef PG8_SCHED
}

#define EPI_LOOP_BEGIN \
    const int row0 = u.pm * BM + wr * 64 + fr, colb = u.pn * BM + wc * 32 + 8 * fq; \
    _Pragma("unroll") for (int ai = 0; ai < 2; ++ai) _Pragma("unroll") for (int m = 0; m < 4; ++m) { const size_t row = (size_t)(row0 + ai * HALF + m * 16); \
    _Pragma("unroll") for (int bj = 0; bj < 2; ++bj) { const int col = colb + bj * HALF; f32x4 v0 = acc[ai][bj][m][0], v1 = acc[ai][bj][m][1];
#define EPI_LOOP_END } }
#define EPI_SIG typedef const f32x4 (&AccT)[2][2][4][2]; __device__ __forceinline__ void operator()(AccT acc, const Unit& u, int wr, int wc, int fr, int fq) const

__device__ __forceinline__ void st_bf16x8(bf16_t* p, f32x4 v0, f32x4 v1) { u32x4 w; w.x = pk2(v0[0], v0[1]); w.y = pk2(v0[2], v0[3]); w.z = pk2(v1[0], v1[1]); w.w = pk2(v1[2], v1[3]); *(u32x4*)p = w; }
__device__ __forceinline__ void ld_bf16x8(const bf16_t* p, f32x4& v0, f32x4& v1) { const u32x4 w = *(const u32x4*)p; v0 = (f32x4){bflo(w.x), bfhi(w.x), bflo(w.y), bfhi(w.y)}; v1 = (f32x4){bflo(w.z), bfhi(w.z), bflo(w.w), bfhi(w.w)}; }

struct EpiInproj { bf16_t *Prw, *Pgm, *G; EPI_SIG {
    bf16_t* base; int ld, cofs; bool sig = false;
    if (u.pn < 7) { base = Prw; ld = RWC; cofs = 0; } else if (u.pn < 11) { base = Pgm; ld = 1024; cofs = 7 * BM; } else { base = G; ld = 2048; cofs = 11 * BM; sig = true; }
    EPI_LOOP_BEGIN
        if (sig) {
#pragma unroll
            for (int j = 0; j < 4; ++j) { v0[j] = sigmoidf_(v0[j]); v1[j] = sigmoidf_(v1[j]); } }
        st_bf16x8(base + row * ld + (col - cofs), v0, v1);
    EPI_LOOP_END
} };
struct EpiLora { bf16_t* OUT; EPI_SIG {
    const int kind = u.pn >> 1; bf16_t* base = OUT + (size_t)kind * (U / 2) - kind * 512;
    EPI_LOOP_BEGIN
        st_bf16x8(base + row * 512 + col, v0, v1);
    EPI_LOOP_END
} };
struct EpiVres { const bf16_t *V0, *VF; bf16_t* V; int ldv; const float* v0res; EPI_SIG {
    EPI_LOOP_BEGIN
        f32x4 a0, a1, f0, f1; ld_bf16x8(V0 + row * 512 + col, a0, a1); ld_bf16x8(VF + row * 512 + col, f0, f1);
        const f32x4 b0 = *(const f32x4*)(v0res + col), b1 = *(const f32x4*)(v0res + col + 4);
#pragma unroll
        for (int j = 0; j < 4; ++j) { v0[j] = a0[j] + (f0[j] - a0[j]) * sigmoidf_(b0[j] + v0[j]); v1[j] = a1[j] + (f1[j] - a1[j]) * sigmoidf_(b1[j] + v1[j]); }
        st_bf16x8(V + row * ldv + col, v0, v1);
    EPI_LOOP_END
} };
struct EpiMergeF { const bf16_t* G; bf16_t* MG;
    __device__ __forceinline__ void mid(f32x4 (&acc)[2][2][4][2], const Unit& u, int wr, int wc, int fr, int fq) const {
        const int row0 = u.pm * BM + wr * 64 + fr, colb = u.pn * BM + wc * 32 + 8 * fq;
#pragma unroll
        for (int ai = 0; ai < 2; ++ai)
#pragma unroll
            for (int m = 0; m < 4; ++m) { const size_t row = (size_t)(row0 + ai * HALF + m * 16);
#pragma unroll
                for (int bj = 0; bj < 2; ++bj) { const int col = colb + bj * HALF;
                    f32x4 ga0, ga1, gb0, gb1; ld_bf16x8(G + row * 2048 + col, ga0, ga1); ld_bf16x8(G + row * 2048 + 1024 + col, gb0, gb1);
#pragma unroll
                    for (int j = 0; j < 4; ++j) { acc[ai][bj][m][0][j] *= gb0[j] * rcpf_(ga0[j]); acc[ai][bj][m][1][j] *= gb1[j] * rcpf_(ga1[j]); } }
                }
    }
    EPI_SIG {
    EPI_LOOP_BEGIN
        f32x4 g0, g1; ld_bf16x8(G + row * 2048 + col, g0, g1);
        st_bf16x8(MG + row * 1024 + col, g0 * v0, g1 * v1);
    EPI_LOOP_END
} };
struct EpiResid { const float* xin; float* xout; const float* gate; EPI_SIG {
    const float* gb = gate + (size_t)(u.pm >> 4) * NMOD;
    EPI_LOOP_BEGIN
        const f32x4 g0 = *(const f32x4*)(gb + col), g1 = *(const f32x4*)(gb + col + 4);
        const f32x4 x0 = *(const f32x4*)(xin + row * 1024 + col), x1 = *(const f32x4*)(xin + row * 1024 + col + 4);
        *(f32x4*)(xout + row * 1024 + col) = x0 + g0 * v0; *(f32x4*)(xout + row * 1024 + col + 4) = x1 + g1 * v1;
    EPI_LOOP_END
} };
struct EpiFF1 { bf16_t* FH; EPI_SIG {
    EPI_LOOP_BEGIN
#pragma unroll
        for (int j = 0; j < 4; ++j) { float a = fmaxf(v0[j], 0.f), b = fmaxf(v1[j], 0.f); v0[j] = a * a; v1[j] = b * b; }
        st_bf16x8(FH + row * 4096 + col, v0, v1);
    EPI_LOOP_END
} };
}

__device__ __forceinline__ void transpose_item(const float* W, int K, int N, bf16_t* WT, int ldo, LAS float* scr, int item, int lane) {
    const int nblk = N / 32, kb = item / nblk, nb = item % nblk, k0 = 64 * kb, n0 = 32 * nb;
    float tv[32];
#pragma unroll
    for (int i = 0; i < 32; ++i) tv[i] = W[(size_t)(k0 + 2 * i + (lane >> 5)) * N + n0 + (lane & 31)];
#pragma unroll
    for (int i = 0; i < 32; ++i) scr[(2 * i + (lane >> 5)) * 33 + (lane & 31)] = tv[i];
    asm volatile("s_waitcnt lgkmcnt(0)" ::: "memory");
    const int c = lane & 7;
#pragma unroll
    for (int j = 0; j < 4; ++j) { const int n = (lane >> 3) + 8 * j; const LAS float* s = scr + (8 * c) * 33 + n;
        u32x4 o; o.x = f2bf(s[0 * 33]) | (f2bf(s[1 * 33]) << 16); o.y = f2bf(s[2 * 33]) | (f2bf(s[3 * 33]) << 16); o.z = f2bf(s[4 * 33]) | (f2bf(s[5 * 33]) << 16); o.w = f2bf(s[6 * 33]) | (f2bf(s[7 * 33]) << 16);
        *(u32x4*)(WT + (size_t)(n0 + n) * ldo + k0 + 8 * c) = o; }
    asm volatile("s_waitcnt lgkmcnt(0)" ::: "memory");
}

__device__ __forceinline__ void prologue(const Params& p, LAS unsigned char* lds, int tid, int lane, int wave, int bid, int G) {
    bf16_t* Wb = (bf16_t*)p.ws;
    {
        LAS float* scr = (LAS float*)(lds + wave * 16384);
        const int gw = bid * 8 + wave, NGW = G * 8;
        constexpr int I_IN = 16 * 152, I_BR = 8 * 32, I_OUT = 16 * 32, I_FF1 = 16 * 128, I_FF2 = 64 * 32, I_L = I_IN + 2 * I_BR + I_OUT + I_FF1 + I_FF2;
        for (int it = gw; it < NL * I_L; it += NGW) {
            const int l = it / I_L; int r = it % I_L; bf16_t* wl = Wb + (size_t)l * LW;
            if (r < I_IN) { transpose_item(GP(p.w_in) + (size_t)l * 1024 * 4864, 1024, 4864, wl + O_IN, 1024, scr, r, lane); continue; } r -= I_IN;
            if (r < I_BR) { transpose_item(GP(p.w_br_rw) + (size_t)l * 512 * 1024, 512, 1024, wl + O_BR1 + 512, 1024, scr, r, lane); continue; } r -= I_BR;
            if (r < I_BR) { transpose_item(GP(p.w_br_gm) + (size_t)l * 512 * 1024, 512, 1024, wl + O_BR1, 1024, scr, r, lane); continue; } r -= I_BR;
            if (r < I_OUT) { transpose_item(GP(p.w_out) + (size_t)l * 1024 * 1024, 1024, 1024, wl + O_OUT, 1024, scr, r, lane); continue; } r -= I_OUT;
            if (r < I_FF1) { transpose_item(GP(p.w_ff1) + (size_t)l * 1024 * 4096, 1024, 4096, wl + O_FF1, 1024, scr, r, lane); continue; } r -= I_FF1;
            transpose_item(GP(p.w_ff2) + (size_t)l * 4096 * 1024, 4096, 1024, wl + O_FF2, 4096, scr, r, lane);
        }
    }
    {
        const int gt = bid * 512 + tid, NT = G * 512;
        for (int idx = gt; idx < NL * 1536 * 256; idx += NT) {
            const int l = idx / (1536 * 256), r = idx % (1536 * 256), n = r >> 8, k = r & 255; float v = 0.f;
            if (n < 512) { if (k < 64) v = GP(p.w2_decay)[((size_t)l * 64 + k) * 512 + n]; }
            else if (n < 1024) { if (k >= 64 && k < 128) v = GP(p.w2_aaa)[((size_t)l * 64 + (k - 64)) * 512 + (n - 512)]; }
            else { if (k >= 128) v = GP(p.w2_gate)[((size_t)l * 128 + (k - 128)) * 512 + (n - 1024)]; }
            Wb[(size_t)l * LW + O_LORA + r] = (bf16_t)f2bf(v);
        }
        for (int idx = gt; idx < (NL - 1) * 512 * 512; idx += NT) {
            const int l1 = idx / (512 * 512), r = idx % (512 * 512), n = r >> 9, k = r & 511; float s = 0.f;
            const float* w1 = GP(p.w1_res) + ((size_t)l1 * 512 + k) * 32; const float* w2 = GP(p.w2_res) + (size_t)l1 * 32 * 512 + n;
            float w1v[32], w2v[32];
#pragma unroll
            for (int q = 0; q < 32; ++q) { w1v[q] = w1[q]; w2v[q] = w2[(size_t)q * 512]; }
#pragma unroll
            for (int q = 0; q < 32; ++q) s += w1v[q] * w2v[q];
            Wb[(size_t)(l1 + 1) * LW + O_V12 + r] = (bf16_t)f2bf(s);
        }
        for (int idx = gt; idx < NL * 4 * 128 * 128; idx += NT) {
            const int l = idx / 65536, r = idx % 65536, i = (r >> 7) & 127, j = r & 127;
            const float v = ((i >> 6) >= (j >> 6)) ? GP(p.w_sp)[idx] : 0.f;
            Wb[(size_t)l * LW + O_WS + r] = (bf16_t)f2bf(v);
        }
    }
    __syncthreads();
    {
        LAS float* cact = (LAS float*)lds; LAS float* part = (LAS float*)(lds + 65536);
        for (int i = tid; i < NB * DM; i += 512) { const float v = GP(p.c)[i]; cact[i] = v * sigmoidf_(v); }
        __syncthreads();
        float* mod = (float*)(p.ws + WS_MOD);
        const int ks = tid >> 6, nl = tid & 63;
        for (int it = bid; it < NL * 96; it += G) {
            const int l = it / 96, n0 = (it % 96) * 64;
            float a[16];
#pragma unroll
            for (int b = 0; b < 16; ++b) a[b] = 0.f;
            const float* wp = GP(p.w_ada) + ((size_t)l * 1024 + ks * 128) * NMOD + n0 + nl;
            for (int k0 = 0; k0 < 128; k0 += 16) { float w[16];
#pragma unroll
                for (int kk = 0; kk < 16; ++kk) w[kk] = wp[(size_t)(k0 + kk) * NMOD];
#pragma unroll
                for (int kk = 0; kk < 16; ++kk)
#pragma unroll
                    for (int b = 0; b < 16; ++b) a[b] += cact[b * 1024 + ks * 128 + k0 + kk] * w[kk]; }
#pragma unroll
            for (int b = 0; b < 16; ++b) part[(ks * 16 + b) * 64 + nl] = a[b];
            __syncthreads();
#pragma unroll
            for (int e = 0; e < 2; ++e) { const int o = tid + 512 * e, b = o >> 6, n2 = o & 63; float s = GP(p.b_ada)[(size_t)l * NMOD + n0 + n2];
#pragma unroll
                for (int q = 0; q < 8; ++q) s += part[(q * 16 + b) * 64 + n2];
                mod[((size_t)l * NB + b) * NMOD + n0 + n2] = s; }
            __syncthreads();
        }
    }
}

__device__ __forceinline__ void norm_phase(const float* __restrict__ x, const float* __restrict__ gain, const float* __restrict__ modl, int shofs, bf16_t* __restrict__ H, int gw, int NGW, int lane) {
    for (int m0 = gw; m0 < M; m0 += 4 * NGW) {
        f32x4 v[4][4]; float s[4];
#pragma unroll
        for (int r = 0; r < 4; ++r) { const f32x4* xr = (const f32x4*)(x + (size_t)(m0 + r * NGW) * DM) + lane;
#pragma unroll
            for (int j = 0; j < 4; ++j) v[r][j] = xr[64 * j]; }
#pragma unroll
        for (int r = 0; r < 4; ++r) { s[r] = 0.f;
#pragma unroll
            for (int j = 0; j < 4; ++j) s[r] += (v[r][j].x * v[r][j].x + v[r][j].y * v[r][j].y) + (v[r][j].z * v[r][j].z + v[r][j].w * v[r][j].w); }
#pragma unroll
        for (int r = 0; r < 4; ++r) { const int m = m0 + r * NGW;
            const float rstd = rsqrtf(wave_sum(s[r]) * (1.f / DM) + 1e-6f);
            const float* mb = modl + (size_t)(m >> 12) * NMOD + shofs;
            u32x2* o = (u32x2*)(H + (size_t)m * DM) + lane;
#pragma unroll
            for (int j = 0; j < 4; ++j) { const int col = 4 * lane + 256 * j;
                const f32x4 g4 = *(const f32x4*)(gain + col), sh = *(const f32x4*)(mb + col), sc = *(const f32x4*)(mb + 1024 + col);
                const f32x4 h = (v[r][j] * rstd * g4) * (sc + 1.f) + sh;
                u32x2 w; w.x = pk2(h.x, h.y); w.y = pk2(h.z, h.w); o[64 * j] = w; } }
    }
}
__device__ __forceinline__ void final_norm(float* x, const float* __restrict__ gain, int gw, int NGW, int lane) {
    for (int m0 = gw; m0 < M; m0 += 4 * NGW) {
        f32x4 v[4][4]; float s[4];
#pragma unroll
        for (int r = 0; r < 4; ++r) { const f32x4* xr = (const f32x4*)(x + (size_t)(m0 + r * NGW) * DM) + lane;
#pragma unroll
            for (int j = 0; j < 4; ++j) v[r][j] = xr[64 * j]; }
#pragma unroll
        for (int r = 0; r < 4; ++r) { s[r] = 0.f;
#pragma unroll
            for (int j = 0; j < 4; ++j) s[r] += (v[r][j].x * v[r][j].x + v[r][j].y * v[r][j].y) + (v[r][j].z * v[r][j].z + v[r][j].w * v[r][j].w); }
#pragma unroll
        for (int r = 0; r < 4; ++r) { f32x4* xr = (f32x4*)(x + (size_t)(m0 + r * NGW) * DM) + lane;
            const float rstd = rsqrtf(wave_sum(s[r]) * (1.f / DM) + 1e-6f);
#pragma unroll
            for (int j = 0; j < 4; ++j) { const f32x4 g4 = *(const f32x4*)(gain + 4 * lane + 256 * j); xr[64 * j] = v[r][j] * rstd * g4; } }
    }
}

__device__ __forceinline__ void prep1_phase(const bf16_t* __restrict__ Prw, const float* __restrict__ mu, bf16_t* __restrict__ R, bf16_t* __restrict__ K0, bf16_t* __restrict__ V0, bf16_t* __restrict__ LIN, int gt, int NT) {
    constexpr int CH = RWC / 8;
    for (int idx0 = gt; idx0 < M * CH; idx0 += 8 * NT) {
        u32x4 cw[8], pw[8]; f32x4 m0[8], m1[8];
#pragma unroll
        for (int u = 0; u < 8; ++u) { const int idx = idx0 + u * NT, m = idx / CH, col = (idx % CH) * 8;
            cw[u] = *(const u32x4*)(Prw + (size_t)m * RWC + col);
            pw[u] = ((m & (SEQ - 1)) != 0) ? *(const u32x4*)(Prw + (size_t)(m - 1) * RWC + col) : (u32x4){0u, 0u, 0u, 0u};
            m0[u] = *(const f32x4*)(mu + col); m1[u] = *(const f32x4*)(mu + col + 4); }
#pragma unroll
        for (int u = 0; u < 8; ++u) { const int idx = idx0 + u * NT, m = idx / CH, col = (idx % CH) * 8;
            const f32x4 c0 = (f32x4){bflo(cw[u].x), bfhi(cw[u].x), bflo(cw[u].y), bfhi(cw[u].y)}, c1 = (f32x4){bflo(cw[u].z), bfhi(cw[u].z), bflo(cw[u].w), bfhi(cw[u].w)};
            const f32x4 p0 = (f32x4){bflo(pw[u].x), bfhi(pw[u].x), bflo(pw[u].y), bfhi(pw[u].y)}, p1 = (f32x4){bflo(pw[u].z), bfhi(pw[u].z), bflo(pw[u].w), bfhi(pw[u].w)};
            f32x4 x0 = c0 + (p0 - c0) * m0[u], x1 = c1 + (p1 - c1) * m1[u];
            bf16_t* dst;
            if (col < 512) dst = R + (size_t)m * 512 + col;
            else if (col < 1024) dst = K0 + (size_t)m * 512 + (col - 512);
            else if (col < 1536) dst = V0 + (size_t)m * 512 + (col - 1024);
            else { dst = LIN + (size_t)m * 256 + (col - 1536);
                if (col < 1600) {
#pragma unroll
                    for (int j = 0; j < 4; ++j) { x0[j] = tanhf_(x0[j]); x1[j] = tanhf_(x1[j]); } }
                else if (col >= 1664) {
#pragma unroll
                    for (int j = 0; j < 4; ++j) { x0[j] = sigmoidf_(x0[j]); x1[j] = sigmoidf_(x1[j]); } } }
            pg8::st_bf16x8(dst, x0, x1); }
    }
}

__device__ __forceinline__ void gmlp_item(LAS unsigned char* lds, bf16_t* Pgm, bf16_t* Yo, const bf16_t* __restrict__ Wsm, const float* __restrict__ lnw, const float* __restrict__ lnb, const float* __restrict__ bsp, int item, int tid, int lane, int wave) {
    LAS float* stats = (LAS float*)lds;
    LAS bf16_t* Vs = (LAS bf16_t*)(lds + 1024);
    constexpr int VP = 130;
    const size_t m0 = (size_t)item * 128;
#pragma unroll
    for (int hb = 0; hb < 2; ++hb) {
        u32x4 raw[8];
#pragma unroll
        for (int e = 0; e < 8; ++e) raw[e] = *(const u32x4*)(Pgm + (m0 + wave * 16 + hb * 8 + e) * 1024 + 512 + lane * 8);
#pragma unroll
        for (int e = 0; e < 8; ++e) { const int tk = wave * 16 + hb * 8 + e; float s = 0.f, ss = 0.f;
            const unsigned w4[4] = {raw[e].x, raw[e].y, raw[e].z, raw[e].w};
#pragma unroll
            for (int j = 0; j < 4; ++j) { const float g0 = gelu1(bflo(w4[j])), g1 = gelu1(bfhi(w4[j])); s += g0 + g1; ss += g0 * g0 + g1 * g1; }
            s = wave_sum(s); ss = wave_sum(ss);
            const float mean = s * (1.f / 512.f), var = fmaxf(ss * (1.f / 512.f) - mean * mean, 0.f);
            if (lane == 0) { stats[tk * 2] = mean; stats[tk * 2 + 1] = rsqrtf(var + 1e-5f); } }
    }
    __syncthreads();
    const int fr = lane & 15, fq = lane >> 4;
    const int i = 16 * wave + fr;
#pragma unroll 1
    for (int g = 0; g < 4; ++g) {
        u32x4 vraw[4]; bf16x8 af[4]; u32x2 uw[8];
#pragma unroll
        for (int it = 0; it < 4; ++it) { const int q = tid + 512 * it, j = q >> 4, dc = q & 15; vraw[it] = *(const u32x4*)(Pgm + (m0 + j) * 1024 + 512 + g * 128 + dc * 8); }
#pragma unroll
        for (int kc = 0; kc < 4; ++kc) af[kc] = *(const bf16x8*)(Wsm + ((size_t)g * 128 + i) * 128 + kc * 32 + fq * 8);
        bf16_t* urow = Pgm + (m0 + i) * 1024 + g * 128 + fq * 4;
#pragma unroll
        for (int dt = 0; dt < 8; ++dt) uw[dt] = *(const u32x2*)(urow + dt * 16);
        const float bs = bsp[g * 128 + i];
#pragma unroll
        for (int it = 0; it < 4; ++it) { const int q = tid + 512 * it, j = q >> 4, dc = q & 15;
            const float mean = stats[j * 2], rstd = stats[j * 2 + 1];
            const f32x4 w0 = *(const f32x4*)(lnw + g * 128 + dc * 8), w1 = *(const f32x4*)(lnw + g * 128 + dc * 8 + 4);
            const f32x4 b0 = *(const f32x4*)(lnb + g * 128 + dc * 8), b1 = *(const f32x4*)(lnb + g * 128 + dc * 8 + 4);
            f32x4 a0 = (f32x4){bflo(vraw[it].x), bfhi(vraw[it].x), bflo(vraw[it].y), bfhi(vraw[it].y)}, a1 = (f32x4){bflo(vraw[it].z), bfhi(vraw[it].z), bflo(vraw[it].w), bfhi(vraw[it].w)};
#pragma unroll
            for (int e = 0; e < 4; ++e) { a0[e] = (gelu1(a0[e]) - mean) * rstd * w0[e] + b0[e]; a1[e] = (gelu1(a1[e]) - mean) * rstd * w1[e] + b1[e]; }
            LAS unsigned* dst = (LAS unsigned*)(Vs + j * VP + dc * 8);
            dst[0] = pk2(a0[0], a0[1]); dst[1] = pk2(a0[2], a0[3]); dst[2] = pk2(a1[0], a1[1]); dst[3] = pk2(a1[2], a1[3]); }
        __syncthreads();
        f32x4 acc[8];
#pragma unroll
        for (int dt = 0; dt < 8; ++dt) { acc[dt] = (f32x4){0.f, 0.f, 0.f, 0.f};
#pragma unroll
            for (int kc = 0; kc < 4; ++kc) { bf16x8 bfv;
#pragma unroll
                for (int e = 0; e < 8; ++e) bfv[e] = (short)Vs[(kc * 32 + fq * 8 + e) * VP + dt * 16 + fr];
                acc[dt] = __builtin_amdgcn_mfma_f32_16x16x32_bf16(bfv, af[kc], acc[dt], 0, 0, 0); } }
#pragma unroll
        for (int dt = 0; dt < 8; ++dt) {
            const float y0 = gelu1(bflo(uw[dt].x)) * (acc[dt][0] + bs), y1 = gelu1(bfhi(uw[dt].x)) * (acc[dt][1] + bs), y2 = gelu1(bflo(uw[dt].y)) * (acc[dt][2] + bs), y3 = gelu1(bfhi(uw[dt].y)) * (acc[dt][3] + bs);
            u32x2 o; o.x = pk2(y0, y1); o.y = pk2(y2, y3); *(u32x2*)(Yo + (m0 + i) * 1024 + g * 128 + fq * 4 + dt * 16) = o; }
        __syncthreads();
    }
}

__device__ __forceinline__ void scan_phase(LAS unsigned char* lds, const bf16_t* __restrict__ R, const bf16_t* __restrict__ K0, const bf16_t* __restrict__ AS, const bf16_t* __restrict__ OMD, const bf16_t* __restrict__ V, int ldv,
                                           bf16_t* __restrict__ Y, float* __restrict__ CB, const float* k_k, const float* k_a, const float* r_k, const float* w0p, const float* a0p, int bid, int tid) {
    constexpr int CT = 32, VF32 = CT * 64, BUFF = 6 * VF32;
    LAS float* buf = (LAS float*)lds;
    LAS float* ybuf = (LAS float*)(lds + 2 * BUFF * 4);
    const int bh = bid >> 1, half = bid & 1, b = bh >> 3, h = bh & 7;
    const int lane = tid & 63, wave = __builtin_amdgcn_readfirstlane(tid >> 6);
    const size_t mrow0 = (size_t)b * SEQ;
    constexpr int NCH = SEQ / CT;
    if (wave >= 4) {
        const int lt = tid - 256, tt = lt >> 4, jg = lt & 15, jl = 4 * jg, colL = h * 64 + jl;
        const f32x4 kk4 = *(const f32x4*)(k_k + colL), ka4 = *(const f32x4*)(k_a + colL), rk4 = *(const f32x4*)(r_k + colL), wz4 = *(const f32x4*)(w0p + colL), az4 = *(const f32x4*)(a0p + colL);
        u32x2 Pr0, Pk0, Pa0, Po0, Pv0, Pr1, Pk1, Pa1, Po1, Pv1;
#define SCAN_LOAD1(c, tk, Pr, Pk, Pa, Po, Pv) do { const size_t m_ = mrow0 + (size_t)(c) * CT + (tk); \
        Pr = *(const u32x2*)(R + m_ * 512 + colL); Pk = *(const u32x2*)(K0 + m_ * 512 + colL); Pa = *(const u32x2*)(AS + m_ * 512 + colL); \
        Po = *(const u32x2*)(OMD + m_ * 512 + colL); Pv = *(const u32x2*)(V + m_ * (size_t)ldv + colL); } while (0)
#define SCAN_LOAD(c) do { SCAN_LOAD1(c, tt, Pr0, Pk0, Pa0, Po0, Pv0); SCAN_LOAD1(c, tt + 16, Pr1, Pk1, Pa1, Po1, Pv1); } while (0)
#define SCAN_FILL1(c, nb, tk, Pr, Pk, Pa, Po, Pv) do { LAS float* B_ = buf + (nb) * BUFF + (tk) * 64 + jl; \
        const f32x4 r4 = (f32x4){bflo(Pr.x), bfhi(Pr.x), bflo(Pr.y), bfhi(Pr.y)}, k4 = (f32x4){bflo(Pk.x), bfhi(Pk.x), bflo(Pk.y), bfhi(Pk.y)}; \
        const f32x4 al = (f32x4){bflo(Pa.x), bfhi(Pa.x), bflo(Pa.y), bfhi(Pa.y)}, ol = (f32x4){bflo(Po.x), bfhi(Po.x), bflo(Po.y), bfhi(Po.y)}; \
        f32x4 a4, w4; _Pragma("unroll") for (int e_ = 0; e_ < 4; ++e_) { a4[e_] = sigmoidf_(az4[e_] + al[e_]); w4[e_] = decay_of(wz4[e_] + ol[e_]); } \
        const f32x4 q4 = k4 * kk4; const float ssq = row_sum16((q4.x * q4.x + q4.y * q4.y) + (q4.z * q4.z + q4.w * q4.w)); const float inv = 1.f / fmaxf(sqrtf(ssq), 1e-12f); \
        const f32x4 n4 = q4 * inv; const f32x4 km4 = k4 * ((a4 - 1.f) * ka4 + 1.f); const f32x4 bo4 = r4 * km4 * rk4; \
        const float bon = row_sum16((bo4.x + bo4.y) + (bo4.z + bo4.w)); \
        *(LAS f32x4*)(B_ + 0 * VF32) = w4; *(LAS f32x4*)(B_ + 1 * VF32) = -n4; *(LAS f32x4*)(B_ + 2 * VF32) = n4 * a4; *(LAS f32x4*)(B_ + 3 * VF32) = km4; *(LAS f32x4*)(B_ + 4 * VF32) = r4; \
        *(LAS f32x4*)(B_ + 5 * VF32) = (f32x4){bflo(Pv.x), bfhi(Pv.x), bflo(Pv.y), bfhi(Pv.y)}; \
        if (half == 0 && jg == 0) CB[(mrow0 + (size_t)(c) * CT + (tk)) * 8 + h] = bon; } while (0)
#define SCAN_FILL(c, nb) do { SCAN_FILL1(c, nb, tt, Pr0, Pk0, Pa0, Po0, Pv0); SCAN_FILL1(c, nb, tt + 16, Pr1, Pk1, Pa1, Po1, Pv1); } while (0)
#define SCAN_WRITE(c, yb_) do { const int t2_ = lt >> 3, ip_ = lt & 7; const size_t m_ = mrow0 + (size_t)(c) * CT + t2_; \
        const f32x4 yy_ = *(const LAS f32x4*)((yb_) + t2_ * 32 + 4 * ip_); u32x2 o_; o_.x = pk2(yy_.x, yy_.y); o_.y = pk2(yy_.z, yy_.w); *(u32x2*)(Y + m_ * 512 + h * 64 + half * 32 + 4 * ip_) = o_; } while (0)
        SCAN_LOAD(0); SCAN_FILL(0, 0); SCAN_LOAD(1);
        __syncthreads();
#pragma unroll 1
        for (int c = 0; c < NCH; ++c) {
            const int cur = c & 1;
            if (c > 0) SCAN_WRITE(c - 1, ybuf + (cur ^ 1) * (CT * 32));
            if (c + 1 < NCH) { SCAN_FILL(c + 1, cur ^ 1); if (c + 2 < NCH) SCAN_LOAD(c + 2); }
            __syncthreads();
        }
        SCAN_WRITE(NCH - 1, ybuf + ((NCH - 1) & 1) * (CT * 32));
#undef SCAN_LOAD1
#undef SCAN_LOAD
#undef SCAN_FILL1
#undef SCAN_FILL
#undef SCAN_WRITE
    } else {
        const int rloc = wave * 8 + (lane >> 3), irow = half * 32 + rloc, jq = lane & 7, j0 = jq * 8;
        f32x2 s0 = (f32x2){0.f, 0.f}, s1 = s0, s2 = s0, s3 = s0;
        const unsigned lds0 = (unsigned)(size_t)buf;
        __syncthreads();
#define DSR128(dst, addr, off) asm volatile("ds_read_b128 %0, %1 offset:%2" : "=v"(dst) : "v"(addr), "n"(off))
#define DSR32(dst, addr, off) asm volatile("ds_read_b32 %0, %1 offset:%2" : "=v"(dst) : "v"(addr), "n"(off))
#define SC_PART1(PE) const f32x2 pa = (s0 * (f32x2){PE##A0.x, PE##A0.y} + s1 * (f32x2){PE##A0.z, PE##A0.w}) + (s2 * (f32x2){PE##A1.x, PE##A1.y} + s3 * (f32x2){PE##A1.z, PE##A1.w}); \
                const f32x2 v2 = (f32x2){PE##v, PE##v}; \
                const f32x2 t0 = s0 * (f32x2){PE##W0.x, PE##W0.y} + v2 * (f32x2){PE##K0.x, PE##K0.y}, t1 = s1 * (f32x2){PE##W0.z, PE##W0.w} + v2 * (f32x2){PE##K0.z, PE##K0.w}; \
                const f32x2 t2 = s2 * (f32x2){PE##W1.x, PE##W1.y} + v2 * (f32x2){PE##K1.x, PE##K1.y}, t3 = s3 * (f32x2){PE##W1.z, PE##W1.w} + v2 * (f32x2){PE##K1.z, PE##K1.w}; \
                const float sa = red8(pa.x + pa.y); const f32x2 sa2 = (f32x2){sa, sa};
#define SC_PART2(PL, tq_, yk_) s0 = t0 + sa2 * (f32x2){PL##B0.x, PL##B0.y}; s1 = t1 + sa2 * (f32x2){PL##B0.z, PL##B0.w}; s2 = t2 + sa2 * (f32x2){PL##B1.x, PL##B1.y}; s3 = t3 + sa2 * (f32x2){PL##B1.z, PL##B1.w}; \
                { const f32x2 py = (s0 * (f32x2){PL##R0.x, PL##R0.y} + s1 * (f32x2){PL##R0.z, PL##R0.w}) + (s2 * (f32x2){PL##R1.x, PL##R1.y} + s3 * (f32x2){PL##R1.z, PL##R1.w}); \
                  const float y = red8(py.x + py.y); yk_ = (jq == (tq_)) ? y : yk_; }
#pragma unroll 1
        for (int c = 0; c < NCH; ++c) {
            const int cur = c & 1;
            LAS float* yb = ybuf + cur * (CT * 32);
            float yk0 = 0.f, yk1 = 0.f, yk2 = 0.f, yk3 = 0.f;
            const unsigned qa = lds0 + (unsigned)(cur * BUFF + j0) * 4u, va = lds0 + (unsigned)(cur * BUFF + 5 * VF32 + irow) * 4u;
            f32x4 EAA0, EAA1, EAW0, EAW1, EAK0, EAK1, EBA0, EBA1, EBW0, EBW1, EBK0, EBK1, ECA0, ECA1, ECW0, ECW1, ECK0, ECK1, LAB0, LAB1, LAR0, LAR1, LBB0, LBB1, LBR0, LBR1; float EAv, EBv, ECv;
            DSR128(EAA0, qa, 8192); DSR128(EAA1, qa, 8208); DSR128(EAW0, qa, 0); DSR128(EAW1, qa, 16); DSR128(EAK0, qa, 24576); DSR128(EAK1, qa, 24592); DSR32(EAv, va, 0); DSR128(LAB0, qa, 16384); DSR128(LAB1, qa, 16400); DSR128(LAR0, qa, 32768); DSR128(LAR1, qa, 32784); DSR128(EBA0, qa, 8448); DSR128(EBA1, qa, 8464); DSR128(EBW0, qa, 256); DSR128(EBW1, qa, 272); DSR128(EBK0, qa, 24832); DSR128(EBK1, qa, 24848); DSR32(EBv, va, 256);
            { asm volatile("s_waitcnt lgkmcnt(11)" : "+v"(EAA0), "+v"(EAA1), "+v"(EAW0), "+v"(EAW1), "+v"(EAK0), "+v"(EAK1), "+v"(EAv)); DSR128(LBB0, qa, 16640); DSR128(LBB1, qa, 16656); DSR128(LBR0, qa, 33024); DSR128(LBR1, qa, 33040); DSR128(ECA0, qa, 8704); DSR128(ECA1, qa, 8720); DSR128(ECW0, qa, 512); DSR128(ECW1, qa, 528); DSR128(ECK0, qa, 25088); DSR128(ECK1, qa, 25104); DSR32(ECv, va, 512); SC_PART1(EA) asm volatile("s_waitcnt lgkmcnt(15)" : "+v"(LAB0), "+v"(LAB1), "+v"(LAR0), "+v"(LAR1)); SC_PART2(LA, 0, yk0) }
            { asm volatile("s_waitcnt lgkmcnt(11)" : "+v"(EBA0), "+v"(EBA1), "+v"(EBW0), "+v"(EBW1), "+v"(EBK0), "+v"(EBK1), "+v"(EBv)); DSR128(LAB0, qa, 16896); DSR128(LAB1, qa, 16912); DSR128(LAR0, qa, 33280); DSR128(LAR1, qa, 33296); DSR128(EAA0, qa, 8960); DSR128(EAA1, qa, 8976); DSR128(EAW0, qa, 768); DSR128(EAW1, qa, 784); DSR128(EAK0, qa, 25344); DSR128(EAK1, qa, 25360); DSR32(EAv, va, 768); SC_PART1(EB) asm volatile("s_waitcnt lgkmcnt(15)" : "+v"(LBB0), "+v"(LBB1), "+v"(LBR0), "+v"(LBR1)); SC_PART2(LB, 1, yk0) }
            { asm volatile("s_waitcnt lgkmcnt(11)" : "+v"(ECA0), "+v"(ECA1), "+v"(ECW0), "+v"(ECW1), "+v"(ECK0), "+v"(ECK1), "+v"(ECv)); DSR128(LBB0, qa, 17152); DSR128(LBB1, qa, 17168); DSR128(LBR0, qa, 33536); DSR128(LBR1, qa, 33552); DSR128(EBA0, qa, 9216); DSR128(EBA1, qa, 9232); DSR128(EBW0, qa, 1024); DSR128(EBW1, qa, 1040); DSR128(EBK0, qa, 25600); DSR128(EBK1, qa, 25616); DSR32(EBv, va, 1024); SC_PART1(EC) asm volatile("s_waitcnt lgkmcnt(15)" : "+v"(LAB0), "+v"(LAB1), "+v"(LAR0), "+v"(LAR1)); SC_PART2(LA, 2, yk0) }
            { asm volatile("s_waitcnt lgkmcnt(11)" : "+v"(EAA0), "+v"(EAA1), "+v"(EAW0), "+v"(EAW1), "+v"(EAK0), "+v"(EAK1), "+v"(EAv)); DSR128(LAB0, qa, 17408); DSR128(LAB1, qa, 17424); DSR128(LAR0, qa, 33792); DSR128(LAR1, qa, 33808); DSR128(ECA0, qa, 9472); DSR128(ECA1, qa, 9488); DSR128(ECW0, qa, 1280); DSR128(ECW1, qa, 1296); DSR128(ECK0, qa, 25856); DSR128(ECK1, qa, 25872); DSR32(ECv, va, 1280); SC_PART1(EA) asm volatile("s_waitcnt lgkmcnt(15)" : "+v"(LBB0), "+v"(LBB1), "+v"(LBR0), "+v"(LBR1)); SC_PART2(LB, 3, yk0) }
            { asm volatile("s_waitcnt lgkmcnt(11)" : "+v"(EBA0), "+v"(EBA1), "+v"(EBW0), "+v"(EBW1), "+v"(EBK0), "+v"(EBK1), "+v"(EBv)); DSR128(LBB0, qa, 17664); DSR128(LBB1, qa, 17680); DSR128(LBR0, qa, 34048); DSR128(LBR1, qa, 34064); DSR128(EAA0, qa, 9728); DSR128(EAA1, qa, 9744); DSR128(EAW0, qa, 1536); DSR128(EAW1, qa, 1552); DSR128(EAK0, qa, 26112); DSR128(EAK1, qa, 26128); DSR32(EAv, va, 1536); SC_PART1(EB) asm volatile("s_waitcnt lgkmcnt(15)" : "+v"(LAB0), "+v"(LAB1), "+v"(LAR0), "+v"(LAR1)); SC_PART2(LA, 4, yk0) }
            { asm volatile("s_waitcnt lgkmcnt(11)" : "+v"(ECA0), "+v"(ECA1), "+v"(ECW0), "+v"(ECW1), "+v"(ECK0), "+v"(ECK1), "+v"(ECv)); DSR128(LAB0, qa, 17920); DSR128(LAB1, qa, 17936); DSR128(LAR0, qa, 34304); DSR128(LAR1, qa, 34320); DSR128(EBA0, qa, 9984); DSR128(EBA1, qa, 10000); DSR128(EBW0, qa, 1792); DSR128(EBW1, qa, 1808); DSR128(EBK0, qa, 26368); DSR128(EBK1, qa, 26384); DSR32(EBv, va, 1792); SC_PART1(EC) asm volatile("s_waitcnt lgkmcnt(15)" : "+v"(LBB0), "+v"(LBB1), "+v"(LBR0), "+v"(LBR1)); SC_PART2(LB, 5, yk0) }
            { asm volatile("s_waitcnt lgkmcnt(11)" : "+v"(EAA0), "+v"(EAA1), "+v"(EAW0), "+v"(EAW1), "+v"(EAK0), "+v"(EAK1), "+v"(EAv)); DSR128(LBB0, qa, 18176); DSR128(LBB1, qa, 18192); DSR128(LBR0, qa, 34560); DSR128(LBR1, qa, 34576); DSR128(ECA0, qa, 10240); DSR128(ECA1, qa, 10256); DSR128(ECW0, qa, 2048); DSR128(ECW1, qa, 2064); DSR128(ECK0, qa, 26624); DSR128(ECK1, qa, 26640); DSR32(ECv, va, 2048); SC_PART1(EA) asm volatile("s_waitcnt lgkmcnt(15)" : "+v"(LAB0), "+v"(LAB1), "+v"(LAR0), "+v"(LAR1)); SC_PART2(LA, 6, yk0) }
            { asm volatile("s_waitcnt lgkmcnt(11)" : "+v"(EBA0), "+v"(EBA1), "+v"(EBW0), "+v"(EBW1), "+v"(EBK0), "+v"(EBK1), "+v"(EBv)); DSR128(LAB0, qa, 18432); DSR128(LAB1, qa, 18448); DSR128(LAR0, qa, 34816); DSR128(LAR1, qa, 34832); DSR128(EAA0, qa, 10496); DSR128(EAA1, qa, 10512); DSR128(EAW0, qa, 2304); DSR128(EAW1, qa, 2320); DSR128(EAK0, qa, 26880); DSR128(EAK1, qa, 26896); DSR32(EAv, va, 2304); SC_PART1(EB) asm volatile("s_waitcnt lgkmcnt(15)" : "+v"(LBB0), "+v"(LBB1), "+v"(LBR0), "+v"(LBR1)); SC_PART2(LB, 7, yk0) }
            { asm volatile("s_waitcnt lgkmcnt(11)" : "+v"(ECA0), "+v"(ECA1), "+v"(ECW0), "+v"(ECW1), "+v"(ECK0), "+v"(ECK1), "+v"(ECv)); DSR128(LBB0, qa, 18688); DSR128(LBB1, qa, 18704); DSR128(LBR0, qa, 35072); DSR128(LBR1, qa, 35088); DSR128(EBA0, qa, 10752); DSR128(EBA1, qa, 10768); DSR128(EBW0, qa, 2560); DSR128(EBW1, qa, 2576); DSR128(EBK0, qa, 27136); DSR128(EBK1, qa, 27152); DSR32(EBv, va, 2560); SC_PART1(EC) asm volatile("s_waitcnt lgkmcnt(15)" : "+v"(LAB0), "+v"(LAB1), "+v"(LAR0), "+v"(LAR1)); SC_PART2(LA, 0, yk1) }
            { asm volatile("s_waitcnt lgkmcnt(11)" : "+v"(EAA0), "+v"(EAA1), "+v"(EAW0), "+v"(EAW1), "+v"(EAK0), "+v"(EAK1), "+v"(EAv)); DSR128(LAB0, qa, 18944); DSR128(LAB1, qa, 18960); DSR128(LAR0, qa, 35328); DSR128(LAR1, qa, 35344); DSR128(ECA0, qa, 11008); DSR128(ECA1, qa, 11024); DSR128(ECW0, qa, 2816); DSR128(ECW1, qa, 2832); DSR128(ECK0, qa, 27392); DSR128(ECK1, qa, 27408); DSR32(ECv, va, 2816); SC_PART1(EA) asm volatile("s_waitcnt lgkmcnt(15)" : "+v"(LBB0), "+v"(LBB1), "+v"(LBR0), "+v"(LBR1)); SC_PART2(LB, 1, yk1) }
            { asm volatile("s_waitcnt lgkmcnt(11)" : "+v"(EBA0), "+v"(EBA1), "+v"(EBW0), "+v"(EBW1), "+v"(EBK0), "+v"(EBK1), "+v"(EBv)); DSR128(LBB0, qa, 19200); DSR128(LBB1, qa, 19216); DSR128(LBR0, qa, 35584); DSR128(LBR1, qa, 35600); DSR128(EAA0, qa, 11264); DSR128(EAA1, qa, 11280); DSR128(EAW0, qa, 3072); DSR128(EAW1, qa, 3088); DSR128(EAK0, qa, 27648); DSR128(EAK1, qa, 27664); DSR32(EAv, va, 3072); SC_PART1(EB) asm volatile("s_waitcnt lgkmcnt(15)" : "+v"(LAB0), "+v"(LAB1), "+v"(LAR0), "+v"(LAR1)); SC_PART2(LA, 2, yk1) }
            { asm volatile("s_waitcnt lgkmcnt(11)" : "+v"(ECA0), "+v"(ECA1), "+v"(ECW0), "+v"(ECW1), "+v"(ECK0), "+v"(ECK1), "+v"(ECv)); DSR128(LAB0, qa, 19456); DSR128(LAB1, qa, 19472); DSR128(LAR0, qa, 35840); DSR128(LAR1, qa, 35856); DSR128(EBA0, qa, 11520); DSR128(EBA1, qa, 11536); DSR128(EBW0, qa, 3328); DSR128(EBW1, qa, 3344); DSR128(EBK0, qa, 27904); DSR128(EBK1, qa, 27920); DSR32(EBv, va, 3328); SC_PART1(EC) asm volatile("s_waitcnt lgkmcnt(15)" : "+v"(LBB0), "+v"(LBB1), "+v"(LBR0), "+v"(LBR1)); SC_PART2(LB, 3, yk1) }
            { asm volatile("s_waitcnt lgkmcnt(11)" : "+v"(EAA0), "+v"(EAA1), "+v"(EAW0), "+v"(EAW1), "+v"(EAK0), "+v"(EAK1), "+v"(EAv)); DSR128(LBB0, qa, 19712); DSR128(LBB1, qa, 19728); DSR128(LBR0, qa, 36096); DSR128(LBR1, qa, 36112); DSR128(ECA0, qa, 11776); DSR128(ECA1, qa, 11792); DSR128(ECW0, qa, 3584); DSR128(ECW1, qa, 3600); DSR128(ECK0, qa, 28160); DSR128(ECK1, qa, 28176); DSR32(ECv, va, 3584); SC_PART1(EA) asm volatile("s_waitcnt lgkmcnt(15)" : "+v"(LAB0), "+v"(LAB1), "+v"(LAR0), "+v"(LAR1)); SC_PART2(LA, 4, yk1) }
            { asm volatile("s_waitcnt lgkmcnt(11)" : "+v"(EBA0), "+v"(EBA1), "+v"(EBW0), "+v"(EBW1), "+v"(EBK0), "+v"(EBK1), "+v"(EBv)); DSR128(LAB0, qa, 19968); DSR128(LAB1, qa, 19984); DSR128(LAR0, qa, 36352); DSR128(LAR1, qa, 36368); DSR128(EAA0, qa, 12032); DSR128(EAA1, qa, 12048); DSR128(EAW0, qa, 3840); DSR128(EAW1, qa, 3856); DSR128(EAK0, qa, 28416); DSR128(EAK1, qa, 28432); DSR32(EAv, va, 3840); SC_PART1(EB) asm volatile("s_waitcnt lgkmcnt(15)" : "+v"(LBB0), "+v"(LBB1), "+v"(LBR0), "+v"(LBR1)); SC_PART2(LB, 5, yk1) }
            { asm volatile("s_waitcnt lgkmcnt(11)" : "+v"(ECA0), "+v"(ECA1), "+v"(ECW0), "+v"(ECW1), "+v"(ECK0), "+v"(ECK1), "+v"(ECv)); DSR128(LBB0, qa, 20224); DSR128(LBB1, qa, 20240); DSR128(LBR0, qa, 36608); DSR128(LBR1, qa, 36624); DSR128(EBA0, qa, 12288); DSR128(EBA1, qa, 12304); DSR128(EBW0, qa, 4096); DSR128(EBW1, qa, 4112); DSR128(EBK0, qa, 28672); DSR128(EBK1, qa, 28688); DSR32(EBv, va, 4096); SC_PART1(EC) asm volatile("s_waitcnt lgkmcnt(15)" : "+v"(LAB0), "+v"(LAB1), "+v"(LAR0), "+v"(LAR1)); SC_PART2(LA, 6, yk1) }
            { asm volatile("s_waitcnt lgkmcnt(11)" : "+v"(EAA0), "+v"(EAA1), "+v"(EAW0), "+v"(EAW1), "+v"(EAK0), "+v"(EAK1), "+v"(EAv)); DSR128(LAB0, qa, 20480); DSR128(LAB1, qa, 20496); DSR128(LAR0, qa, 36864); DSR128(LAR1, qa, 36880); DSR128(ECA0, qa, 12544); DSR128(ECA1, qa, 12560); DSR128(ECW0, qa, 4352); DSR128(ECW1, qa, 4368); DSR128(ECK0, qa, 28928); DSR128(ECK1, qa, 28944); DSR32(ECv, va, 4352); SC_PART1(EA) asm volatile("s_waitcnt lgkmcnt(15)" : "+v"(LBB0), "+v"(LBB1), "+v"(LBR0), "+v"(LBR1)); SC_PART2(LB, 7, yk1) }
            { asm volatile("s_waitcnt lgkmcnt(11)" : "+v"(EBA0), "+v"(EBA1), "+v"(EBW0), "+v"(EBW1), "+v"(EBK0), "+v"(EBK1), "+v"(EBv)); DSR128(LBB0, qa, 20736); DSR128(LBB1, qa, 20752); DSR128(LBR0, qa, 37120); DSR128(LBR1, qa, 37136); DSR128(EAA0, qa, 12800); DSR128(EAA1, qa, 12816); DSR128(EAW0, qa, 4608); DSR128(EAW1, qa, 4624); DSR128(EAK0, qa, 29184); DSR128(EAK1, qa, 29200); DSR32(EAv, va, 4608); SC_PART1(EB) asm volatile("s_waitcnt lgkmcnt(15)" : "+v"(LAB0), "+v"(LAB1), "+v"(LAR0), "+v"(LAR1)); SC_PART2(LA, 0, yk2) }
            { asm volatile("s_waitcnt lgkmcnt(11)" : "+v"(ECA0), "+v"(ECA1), "+v"(ECW0), "+v"(ECW1), "+v"(ECK0), "+v"(ECK1), "+v"(ECv)); DSR128(LAB0, qa, 20992); DSR128(LAB1, qa, 21008); DSR128(LAR0, qa, 37376); DSR128(LAR1, qa, 37392); DSR128(EBA0, qa, 13056); DSR128(EBA1, qa, 13072); DSR128(EBW0, qa, 4864); DSR128(EBW1, qa, 4880); DSR128(EBK0, qa, 29440); DSR128(EBK1, qa, 29456); DSR32(EBv, va, 4864); SC_PART1(EC) asm volatile("s_waitcnt lgkmcnt(15)" : "+v"(LBB0), "+v"(LBB1), "+v"(LBR0), "+v"(LBR1)); SC_PART2(LB, 1, yk2) }
            { asm volatile("s_waitcnt lgkmcnt(11)" : "+v"(EAA0), "+v"(EAA1), "+v"(EAW0), "+v"(EAW1), "+v"(EAK0), "+v"(EAK1), "+v"(EAv)); DSR128(LBB0, qa, 21248); DSR128(LBB1, qa, 21264); DSR128(LBR0, qa, 37632); DSR128(LBR1, qa, 37648); DSR128(ECA0, qa, 13312); DSR128(ECA1, qa, 13328); DSR128(ECW0, qa, 5120); DSR128(ECW1, qa, 5136); DSR128(ECK0, qa, 29696); DSR128(ECK1, qa, 29712); DSR32(ECv, va, 5120); SC_PART1(EA) asm volatile("s_waitcnt lgkmcnt(15)" : "+v"(LAB0), "+v"(LAB1), "+v"(LAR0), "+v"(LAR1)); SC_PART2(LA, 2, yk2) }
            { asm volatile("s_waitcnt lgkmcnt(11)" : "+v"(EBA0), "+v"(EBA1), "+v"(EBW0), "+v"(EBW1), "+v"(EBK0), "+v"(EBK1), "+v"(EBv)); DSR128(LAB0, qa, 21504); DSR128(LAB1, qa, 21520); DSR128(LAR0, qa, 37888); DSR128(LAR1, qa, 37904); DSR128(EAA0, qa, 13568); DSR128(EAA1, qa, 13584); DSR128(EAW0, qa, 5376); DSR128(EAW1, qa, 5392); DSR128(EAK0, qa, 29952); DSR128(EAK1, qa, 29968); DSR32(EAv, va, 5376); SC_PART1(EB) asm volatile("s_waitcnt lgkmcnt(15)" : "+v"(LBB0), "+v"(LBB1), "+v"(LBR0), "+v"(LBR1)); SC_PART2(LB, 3, yk2) }
            { asm volatile("s_waitcnt lgkmcnt(11)" : "+v"(ECA0), "+v"(ECA1), "+v"(ECW0), "+v"(ECW1), "+v"(ECK0), "+v"(ECK1), "+v"(ECv)); DSR128(LBB0, qa, 21760); DSR128(LBB1, qa, 21776); DSR128(LBR0, qa, 38144); DSR128(LBR1, qa, 38160); DSR128(EBA0, qa, 13824); DSR128(EBA1, qa, 13840); DSR128(EBW0, qa, 5632); DSR128(EBW1, qa, 5648); DSR128(EBK0, qa, 30208); DSR128(EBK1, qa, 30224); DSR32(EBv, va, 5632); SC_PART1(EC) asm volatile("s_waitcnt lgkmcnt(15)" : "+v"(LAB0), "+v"(LAB1), "+v"(LAR0), "+v"(LAR1)); SC_PART2(LA, 4, yk2) }
            { asm volatile("s_waitcnt lgkmcnt(11)" : "+v"(EAA0), "+v"(EAA1), "+v"(EAW0), "+v"(EAW1), "+v"(EAK0), "+v"(EAK1), "+v"(EAv)); DSR128(LAB0, qa, 22016); DSR128(LAB1, qa, 22032); DSR128(LAR0, qa, 38400); DSR128(LAR1, qa, 38416); DSR128(ECA0, qa, 14080); DSR128(ECA1, qa, 14096); DSR128(ECW0, qa, 5888); DSR128(ECW1, qa, 5904); DSR128(ECK0, qa, 30464); DSR128(ECK1, qa, 30480); DSR32(ECv, va, 5888); SC_PART1(EA) asm volatile("s_waitcnt lgkmcnt(15)" : "+v"(LBB0), "+v"(LBB1), "+v"(LBR0), "+v"(LBR1)); SC_PART2(LB, 5, yk2) }
            { asm volatile("s_waitcnt lgkmcnt(11)" : "+v"(EBA0), "+v"(EBA1), "+v"(EBW0), "+v"(EBW1), "+v"(EBK0), "+v"(EBK1), "+v"(EBv)); DSR128(LBB0, qa, 22272); DSR128(LBB1, qa, 22288); DSR128(LBR0, qa, 38656); DSR128(LBR1, qa, 38672); DSR128(EAA0, qa, 14336); DSR128(EAA1, qa, 14352); DSR128(EAW0, qa, 6144); DSR128(EAW1, qa, 6160); DSR128(EAK0, qa, 30720); DSR128(EAK1, qa, 30736); DSR32(EAv, va, 6144); SC_PART1(EB) asm volatile("s_waitcnt lgkmcnt(15)" : "+v"(LAB0), "+v"(LAB1), "+v"(LAR0), "+v"(LAR1)); SC_PART2(LA, 6, yk2) }
            { asm volatile("s_waitcnt lgkmcnt(11)" : "+v"(ECA0), "+v"(ECA1), "+v"(ECW0), "+v"(ECW1), "+v"(ECK0), "+v"(ECK1), "+v"(ECv)); DSR128(LAB0, qa, 22528); DSR128(LAB1, qa, 22544); DSR128(LAR0, qa, 38912); DSR128(LAR1, qa, 38928); DSR128(EBA0, qa, 14592); DSR128(EBA1, qa, 14608); DSR128(EBW0, qa, 6400); DSR128(EBW1, qa, 6416); DSR128(EBK0, qa, 30976); DSR128(EBK1, qa, 30992); DSR32(EBv, va, 6400); SC_PART1(EC) asm volatile("s_waitcnt lgkmcnt(15)" : "+v"(LBB0), "+v"(LBB1), "+v"(LBR0), "+v"(LBR1)); SC_PART2(LB, 7, yk2) }
            { asm volatile("s_waitcnt lgkmcnt(11)" : "+v"(EAA0), "+v"(EAA1), "+v"(EAW0), "+v"(EAW1), "+v"(EAK0), "+v"(EAK1), "+v"(EAv)); DSR128(LBB0, qa, 22784); DSR128(LBB1, qa, 22800); DSR128(LBR0, qa, 39168); DSR128(LBR1, qa, 39184); DSR128(ECA0, qa, 14848); DSR128(ECA1, qa, 14864); DSR128(ECW0, qa, 6656); DSR128(ECW1, qa, 6672); DSR128(ECK0, qa, 31232); DSR128(ECK1, qa, 31248); DSR32(ECv, va, 6656); SC_PART1(EA) asm volatile("s_waitcnt lgkmcnt(15)" : "+v"(LAB0), "+v"(LAB1), "+v"(LAR0), "+v"(LAR1)); SC_PART2(LA, 0, yk3) }
            { asm volatile("s_waitcnt lgkmcnt(11)" : "+v"(EBA0), "+v"(EBA1), "+v"(EBW0), "+v"(EBW1), "+v"(EBK0), "+v"(EBK1), "+v"(EBv)); DSR128(LAB0, qa, 23040); DSR128(LAB1, qa, 23056); DSR128(LAR0, qa, 39424); DSR128(LAR1, qa, 39440); DSR128(EAA0, qa, 15104); DSR128(EAA1, qa, 15120); DSR128(EAW0, qa, 6912); DSR128(EAW1, qa, 6928); DSR128(EAK0, qa, 31488); DSR128(EAK1, qa, 31504); DSR32(EAv, va, 6912); SC_PART1(EB) asm volatile("s_waitcnt lgkmcnt(15)" : "+v"(LBB0), "+v"(LBB1), "+v"(LBR0), "+v"(LBR1)); SC_PART2(LB, 1, yk3) }
            { asm volatile("s_waitcnt lgkmcnt(11)" : "+v"(ECA0), "+v"(ECA1), "+v"(ECW0), "+v"(ECW1), "+v"(ECK0), "+v"(ECK1), "+v"(ECv)); DSR128(LBB0, qa, 23296); DSR128(LBB1, qa, 23312); DSR128(LBR0, qa, 39680); DSR128(LBR1, qa, 39696); DSR128(EBA0, qa, 15360); DSR128(EBA1, qa, 15376); DSR128(EBW0, qa, 7168); DSR128(EBW1, qa, 7184); DSR128(EBK0, qa, 31744); DSR128(EBK1, qa, 31760); DSR32(EBv, va, 7168); SC_PART1(EC) asm volatile("s_waitcnt lgkmcnt(15)" : "+v"(LAB0), "+v"(LAB1), "+v"(LAR0), "+v"(LAR1)); SC_PART2(LA, 2, yk3) }
            { asm volatile("s_waitcnt lgkmcnt(11)" : "+v"(EAA0), "+v"(EAA1), "+v"(EAW0), "+v"(EAW1), "+v"(EAK0), "+v"(EAK1), "+v"(EAv)); DSR128(LAB0, qa, 23552); DSR128(LAB1, qa, 23568); DSR128(LAR0, qa, 39936); DSR128(LAR1, qa, 39952); DSR128(ECA0, qa, 15616); DSR128(ECA1, qa, 15632); DSR128(ECW0, qa, 7424); DSR128(ECW1, qa, 7440); DSR128(ECK0, qa, 32000); DSR128(ECK1, qa, 32016); DSR32(ECv, va, 7424); SC_PART1(EA) asm volatile("s_waitcnt lgkmcnt(15)" : "+v"(LBB0), "+v"(LBB1), "+v"(LBR0), "+v"(LBR1)); SC_PART2(LB, 3, yk3) }
            { asm volatile("s_waitcnt lgkmcnt(11)" : "+v"(EBA0), "+v"(EBA1), "+v"(EBW0), "+v"(EBW1), "+v"(EBK0), "+v"(EBK1), "+v"(EBv)); DSR128(LBB0, qa, 23808); DSR128(LBB1, qa, 23824); DSR128(LBR0, qa, 40192); DSR128(LBR1, qa, 40208); DSR128(EAA0, qa, 15872); DSR128(EAA1, qa, 15888); DSR128(EAW0, qa, 7680); DSR128(EAW1, qa, 7696); DSR128(EAK0, qa, 32256); DSR128(EAK1, qa, 32272); DSR32(EAv, va, 7680); SC_PART1(EB) asm volatile("s_waitcnt lgkmcnt(15)" : "+v"(LAB0), "+v"(LAB1), "+v"(LAR0), "+v"(LAR1)); SC_PART2(LA, 4, yk3) }
            { asm volatile("s_waitcnt lgkmcnt(11)" : "+v"(ECA0), "+v"(ECA1), "+v"(ECW0), "+v"(ECW1), "+v"(ECK0), "+v"(ECK1), "+v"(ECv)); DSR128(LAB0, qa, 24064); DSR128(LAB1, qa, 24080); DSR128(LAR0, qa, 40448); DSR128(LAR1, qa, 40464); DSR128(EBA0, qa, 16128); DSR128(EBA1, qa, 16144); DSR128(EBW0, qa, 7936); DSR128(EBW1, qa, 7952); DSR128(EBK0, qa, 32512); DSR128(EBK1, qa, 32528); DSR32(EBv, va, 7936); SC_PART1(EC) asm volatile("s_waitcnt lgkmcnt(15)" : "+v"(LBB0), "+v"(LBB1), "+v"(LBR0), "+v"(LBR1)); SC_PART2(LB, 5, yk3) }
            { asm volatile("s_waitcnt lgkmcnt(11)" : "+v"(EAA0), "+v"(EAA1), "+v"(EAW0), "+v"(EAW1), "+v"(EAK0), "+v"(EAK1), "+v"(EAv)); DSR128(LBB0, qa, 24320); DSR128(LBB1, qa, 24336); DSR128(LBR0, qa, 40704); DSR128(LBR1, qa, 40720); SC_PART1(EA) asm volatile("s_waitcnt lgkmcnt(11)" : "+v"(LAB0), "+v"(LAB1), "+v"(LAR0), "+v"(LAR1)); SC_PART2(LA, 6, yk3) }
            { asm volatile("s_waitcnt lgkmcnt(4)" : "+v"(EBA0), "+v"(EBA1), "+v"(EBW0), "+v"(EBW1), "+v"(EBK0), "+v"(EBK1), "+v"(EBv)); SC_PART1(EB) asm volatile("s_waitcnt lgkmcnt(0)" : "+v"(LBB0), "+v"(LBB1), "+v"(LBR0), "+v"(LBR1)); SC_PART2(LB, 7, yk3) }
            yb[jq * 32 + rloc] = yk0; yb[(jq + 8) * 32 + rloc] = yk1; yb[(jq + 16) * 32 + rloc] = yk2; yb[(jq + 24) * 32 + rloc] = yk3;
            __syncthreads();
        }
#undef DSR128
#undef DSR32
#undef SC_PART1
#undef SC_PART2
    }
}
__device__ __forceinline__ void post_phase(bf16_t* Y, bf16_t* Yo, const bf16_t* __restrict__ V, int ldv, const bf16_t* __restrict__ GT, const float* __restrict__ CB, const float* gn_w, const float* gn_b, int ghw, int NHW, int tid) {
    const int jp = tid & 31, h = ghw & 7, col = h * 64 + 2 * jp;
    const float gw0 = gn_w[col], gw1 = gn_w[col + 1], gb0 = gn_b[col], gb1 = gn_b[col + 1];
    for (int g0 = ghw; g0 < M * 8; g0 += 8 * NHW) {
        unsigned yw[8], vw[8], gg[8]; float bon[8];
#pragma unroll
        for (int u = 0; u < 8; ++u) { const int g = g0 + u * NHW; const size_t m = (size_t)(g >> 3);
            yw[u] = *(const unsigned*)(Y + m * 512 + col); vw[u] = *(const unsigned*)(V + m * (size_t)ldv + col); gg[u] = *(const unsigned*)(GT + m * 512 + col); bon[u] = CB[g]; }
#pragma unroll
        for (int u = 0; u < 8; ++u) { const int g = g0 + u * NHW; const size_t m = (size_t)(g >> 3);
            const float y0 = bflo(yw[u]), y1 = bfhi(yw[u]);
            const float mean = half_sum(y0 + y1) * (1.f / 64.f);
            const float d0 = y0 - mean, d1 = y1 - mean;
            const float var = half_sum(d0 * d0 + d1 * d1) * (1.f / 64.f);
            const float rs = rsqrtf(var + 64e-5f);
            const float o0 = (d0 * rs * gw0 + gb0 + bon[u] * bflo(vw[u])) * bflo(gg[u]), o1 = (d1 * rs * gw1 + gb1 + bon[u] * bfhi(vw[u])) * bfhi(gg[u]);
            *(unsigned*)(Yo + m * 1024 + col) = pk2(o0, o1); }
    }
}

#define XB_TMO      128
#define XB_XCNT(j)  (256  + 64 * (j))
#define XB_XSUB(j)  (1280 + 64 * (j))
#define XB_XGEN(j)  (2304 + 64 * (j))
#define XB_TOP      3328
#define XB_TOPGEN   3392
#define XCD_BAR_WORDS 3456
#define XB_SPIN_CAP (1u << 18)

__device__ __forceinline__ unsigned xb_ld(unsigned* p)              { return __hip_atomic_load(p, __ATOMIC_RELAXED, __HIP_MEMORY_SCOPE_AGENT); }
__device__ __forceinline__ unsigned xb_add(unsigned* p, unsigned v) { return __hip_atomic_fetch_add(p, v, __ATOMIC_RELAXED, __HIP_MEMORY_SCOPE_AGENT); }
__device__ __forceinline__ unsigned xb_xcc_id() { return (unsigned)__builtin_amdgcn_s_getreg((3 << 11) | 20) & 0xFu; }
#define XB_SPIN(cond, bar) do { unsigned _sp = 0; while (cond) { __builtin_amdgcn_s_sleep(1); \
    if ((++_sp & 255u) == 0u) { if (xb_ld(&(bar)[XB_TMO])) break; if (_sp > XB_SPIN_CAP) { atomicAdd(&(bar)[XB_TMO], 1u); break; } } } } while (0)

struct XcdBarrier {
    unsigned* bar; unsigned x;
    volatile LAS unsigned* st;
};

__device__ __forceinline__ XcdBarrier xcd_barrier_post(unsigned* bar, volatile LAS unsigned* st) {
    XcdBarrier b; b.bar = bar; b.x = xb_xcc_id(); b.st = st;
    if (threadIdx.x == 0) (void)xb_add(&bar[XB_XCNT(b.x)], 1u);
    return b;
}
__device__ __forceinline__ void xcd_barrier_complete(unsigned* bar, unsigned x, unsigned& nloc, unsigned& nx) {
    const unsigned G = gridDim.x * gridDim.y * gridDim.z;
    unsigned sum, cnt, mine, sp = 0u;
    for (;;) {
        sum = 0u; cnt = 0u; mine = 0u;
#pragma unroll
        for (unsigned j = 0; j < 16; ++j) { const unsigned c = xb_ld(&bar[XB_XCNT(j)]); sum += c; cnt += (c > 0u) ? 1u : 0u; mine = (j == x) ? c : mine; }
        if (sum == G) break;
        __builtin_amdgcn_s_sleep(1);
        if ((++sp & 255u) == 0u) { if (xb_ld(&bar[XB_TMO])) break; if (sp > XB_SPIN_CAP) { atomicAdd(&bar[XB_TMO], 1u); break; } }
    }
    nloc = mine > 0u ? mine : 1u; nx = cnt > 0u ? cnt : 1u;
}

__device__ __forceinline__ void xcd_barrier(const XcdBarrier& b) {
    asm volatile("s_waitcnt vmcnt(0)" ::: "memory");
    __syncthreads();
    if (threadIdx.x == 0) {
        unsigned* bar = b.bar;
        __builtin_amdgcn_s_waitcnt(0);
        unsigned nloc = b.st[0], nx = b.st[1];
        if (nloc == 0u) { xcd_barrier_complete(bar, b.x, nloc, nx); b.st[0] = nloc; b.st[1] = nx; }
        const unsigned old = xb_add(&bar[XB_XSUB(b.x)], 1u);
        const unsigned gen = old / nloc;
        if (old + 1u == (gen + 1u) * nloc) {
            __builtin_amdgcn_fence(__ATOMIC_RELEASE, "agent");
            asm volatile("s_waitcnt vmcnt(0)" ::: "memory");
            const unsigned og = xb_add(&bar[XB_TOP], 1u);
            const unsigned tg = og / nx;
            if (og + 1u == (tg + 1u) * nx) xb_add(&bar[XB_TOPGEN], 1u);
            else XB_SPIN(xb_ld(&bar[XB_TOPGEN]) == tg, bar);
            __builtin_amdgcn_fence(__ATOMIC_ACQUIRE, "agent");
            xb_add(&bar[XB_XGEN(b.x)], 1u);
            asm volatile("s_waitcnt vmcnt(0)" ::: "memory");
        } else {
            XB_SPIN(xb_ld(&bar[XB_XGEN(b.x)]) == gen, bar);
            __builtin_amdgcn_fence(__ATOMIC_ACQUIRE, "agent");
            asm volatile("s_waitcnt vmcnt(0)" ::: "memory");
        }
    }
    __syncthreads();
}


#ifndef PHM
#define PHM 0xFFFF
#endif
#define PH(k) ((PHM >> (k)) & 1)
#ifndef DUPM
#define DUPM 0
#endif
#define DUP(k) ((DUPM >> (k)) & 1)
#define REP(k) for (int rep_ = 0; rep_ < PH(k) + DUP(k); ++rep_)
#define WSP(T, off) ((T*)(T GAS*)(q->ws + (off)))
__global__ void __launch_bounds__(512, 2) mega_fwd(Params p_unused) {
    extern __shared__ __attribute__((aligned(16))) unsigned char lds_raw[];
    LAS unsigned char* lds = (LAS unsigned char*)lds_raw;
    cg::grid_group grid = cg::this_grid();
    const int G = gridDim.x, NGW = G * 8, NT = G * 512;
    volatile LAS unsigned* bst = (volatile LAS unsigned*)(lds + 131072);
    if (threadIdx.x < 2) bst[threadIdx.x] = 0u;
    __syncthreads();
    const XcdBarrier xbar = xcd_barrier_post((unsigned*)(((const Params*)__builtin_amdgcn_kernarg_segment_ptr())->ws + WS_BAR), bst);
#define GSYNC() xcd_barrier(xbar)

    REP(0) { const Params* q = opaque_params(); const int t_ = opaque_tid(); prologue(*q, lds, t_, t_ & 63, __builtin_amdgcn_readfirstlane(t_ >> 6), opaque_bid(), G); }
    grid.sync();

#pragma unroll 1
    for (int l = 0; l < NL; ++l) {
        REP(1) { const Params* q = opaque_params(); const int t_ = opaque_tid();
            norm_phase(l == 0 ? GP(q->x) : ((float*)(q->out)), GP(q->norm1_g) + l * DM, WSP(const float, WS_MOD) + (size_t)l * NB * NMOD, 0, WSP(bf16_t, WS_H), opaque_bid() * 8 + (t_ >> 6), NGW, t_ & 63); }
        GSYNC();
        REP(2) { const Params* q = opaque_params(); const bf16_t* Wl = WSP(const bf16_t, 0) + (size_t)l * LW;
            pg8::Gemm g{WSP(bf16_t, WS_H), Wl + O_IN, DM, DM, M, INC, DM}; pg8::StaticOrder S; S.init(M, INC, G, opaque_bid());
            pg8::EpiInproj E{WSP(bf16_t, WS_PRW), WSP(bf16_t, WS_PGM), WSP(bf16_t, WS_G)};
            pg8::gemm_phase<pg8::EpiInproj, true>(lds, g, S, E); }
        GSYNC();
        if (PH(3)) { const Params* q = opaque_params(); const int t_ = opaque_tid(); const bf16_t* Wl = WSP(const bf16_t, 0) + (size_t)l * LW;
            for (int it = opaque_bid(); it < M / 128; it += G)
                gmlp_item(lds, WSP(bf16_t, WS_PGM), WSP(bf16_t, WS_PGM), Wl + O_WS, GP(q->ln_w) + l * 512, GP(q->ln_b) + l * 512, GP(q->b_sp) + l * 512, it, t_, t_ & 63, __builtin_amdgcn_readfirstlane(t_ >> 6)); }
        REP(4) { const Params* q = opaque_params();
            prep1_phase(WSP(bf16_t, WS_PRW), GP(q->mu_shift) + l * RWC, WSP(bf16_t, WS_R), WSP(bf16_t, WS_K0), l == 0 ? WSP(bf16_t, WS_VF) : WSP(bf16_t, WS_V0), WSP(bf16_t, WS_LIN), opaque_bid() * 512 + opaque_tid(), NT); }
        GSYNC();
        REP(5) { const Params* q = opaque_params(); const bf16_t* Wl = WSP(const bf16_t, 0) + (size_t)l * LW;
            pg8::Gemm g{WSP(bf16_t, WS_LIN), Wl + O_LORA, 256, 256, M, 1536, 256}; pg8::StaticOrder S; S.init(M, 1536, G, opaque_bid());
            pg8::EpiLora E{WSP(bf16_t, WS_OMD)};
            pg8::gemm_phase<pg8::EpiLora, true>(lds, g, S, E); }
        if (l > 0) REP(6) { const Params* q = opaque_params(); const bf16_t* Wl = WSP(const bf16_t, 0) + (size_t)l * LW;
            pg8::Gemm g{WSP(bf16_t, WS_V0), Wl + O_V12, 512, 512, M, 512, 512}; pg8::StaticOrder S; S.init(M, 512, G, opaque_bid());
            pg8::EpiVres E{WSP(bf16_t, WS_V0), WSP(bf16_t, WS_VF), WSP(bf16_t, WS_PGM) + 512, 1024, GP(q->v0_res) + (l - 1) * 512};
            pg8::gemm_phase<pg8::EpiVres, true>(lds, g, S, E); }
        GSYNC();
        REP(7) { const Params* q = opaque_params();
            scan_phase(lds, WSP(bf16_t, WS_R), WSP(bf16_t, WS_K0), WSP(bf16_t, WS_ASIG), WSP(bf16_t, WS_OMD), l == 0 ? WSP(bf16_t, WS_VF) : WSP(bf16_t, WS_PGM) + 512, l == 0 ? 512 : 1024,
                       WSP(bf16_t, WS_YRW), WSP(float, WS_CB), GP(q->k_k) + l * 512, GP(q->k_a) + l * 512, GP(q->r_k) + l * 512, GP(q->w0_decay) + l * 512, GP(q->a0) + l * 512, opaque_bid(), opaque_tid()); }
        GSYNC();
        REP(13) { const Params* q = opaque_params(); const int t_ = opaque_tid();
            post_phase(WSP(bf16_t, WS_YRW), WSP(bf16_t, WS_PGM) + 512, l == 0 ? WSP(bf16_t, WS_VF) : WSP(bf16_t, WS_PGM) + 512, l == 0 ? 512 : 1024, WSP(bf16_t, WS_GT), WSP(const float, WS_CB),
                       GP(q->gn_w) + l * 512, GP(q->gn_b) + l * 512, opaque_bid() * 16 + (t_ >> 5), G * 16, t_); }
        GSYNC();
        REP(8) { const Params* q = opaque_params(); const bf16_t* Wl = WSP(const bf16_t, 0) + (size_t)l * LW;
            pg8::StaticOrder S; S.init(M, DM, G, opaque_bid());
            pg8::Gemm g1{WSP(bf16_t, WS_PGM), Wl + O_BR1, 1024, 1024, M, DM, 1024}; pg8::EpiMergeF E1{WSP(bf16_t, WS_G), WSP(bf16_t, WS_MG)};
            pg8::gemm_phase<pg8::EpiMergeF, true, true>(lds, g1, S, E1); }
        GSYNC();
        REP(9) { const Params* q = opaque_params(); const bf16_t* Wl = WSP(const bf16_t, 0) + (size_t)l * LW;
            pg8::Gemm g{WSP(bf16_t, WS_MG), Wl + O_OUT, DM, DM, M, DM, DM}; pg8::StaticOrder S; S.init(M, DM, G, opaque_bid());
            pg8::EpiResid E{l == 0 ? GP(q->x) : ((float*)(q->out)), ((float*)(q->out)), WSP(const float, WS_MOD) + (size_t)l * NB * NMOD + 2 * DM};
            pg8::gemm_phase<pg8::EpiResid, true>(lds, g, S, E); }
        GSYNC();
        REP(10) { const Params* q = opaque_params(); const int t_ = opaque_tid();
            norm_phase(((float*)(q->out)), GP(q->norm2_g) + l * DM, WSP(const float, WS_MOD) + (size_t)l * NB * NMOD, 3 * DM, WSP(bf16_t, WS_H), opaque_bid() * 8 + (t_ >> 6), NGW, t_ & 63); }
        GSYNC();
        REP(11) { const Params* q = opaque_params(); const bf16_t* Wl = WSP(const bf16_t, 0) + (size_t)l * LW;
            pg8::Gemm g{WSP(bf16_t, WS_H), Wl + O_FF1, DM, DM, M, DFF, DM}; pg8::StaticOrder S; S.init(M, DFF, G, opaque_bid());
            pg8::EpiFF1 E{WSP(bf16_t, WS_FH)};
            pg8::gemm_phase<pg8::EpiFF1, true>(lds, g, S, E); }
        GSYNC();
        REP(12) { const Params* q = opaque_params(); const bf16_t* Wl = WSP(const bf16_t, 0) + (size_t)l * LW;
            pg8::Gemm g{WSP(bf16_t, WS_FH), Wl + O_FF2, DFF, DFF, M, DM, DFF}; pg8::StaticOrder S; S.init(M, DM, G, opaque_bid());
            pg8::EpiResid E{((float*)(q->out)), ((float*)(q->out)), WSP(const float, WS_MOD) + (size_t)l * NB * NMOD + 5 * DM};
            pg8::gemm_phase<pg8::EpiResid, true>(lds, g, S, E); }
        GSYNC();
    }
    { const Params* q = opaque_params(); const int t_ = opaque_tid(); final_norm(((float*)(q->out)), GP(q->final_g), opaque_bid() * 8 + (t_ >> 6), NGW, t_ & 63); }
}

extern "C" void kernel_launch(void* const* d_in, const int* in_sizes, int n_in, void* d_out, int out_size, void* d_ws, size_t ws_size, hipStream_t stream) {
    static int grid = 0;
    if (grid == 0) {
        if (n_in != 31 || ws_size < WS_END) { fprintf(stderr, "kernel_launch: unexpected n_in %d / ws_size %zu\n", n_in, ws_size); grid = -1; return; }
        int dev = 0, cus = 0, per_cu = 0;
        hipGetDevice(&dev);
        hipDeviceGetAttribute(&cus, hipDeviceAttributeMultiprocessorCount, dev);
        hipFuncSetAttribute((const void*)mega_fwd, hipFuncAttributeMaxDynamicSharedMemorySize, LDS_BYTES);
        hipOccupancyMaxActiveBlocksPerMultiprocessor(&per_cu, (const void*)mega_fwd, 512, LDS_BYTES);
        if (per_cu < 1) { fprintf(stderr, "kernel_launch: occupancy query says %d blocks/CU\n", per_cu); per_cu = 1; }
        if (cus != 256) { fprintf(stderr, "kernel_launch: built for 256 CUs, found %d\n", cus); grid = -1; return; }
        grid = cus;
        (void)hipGetLastError();
    }
    if (grid < 0) return;
    Params p{};
    const float** pp = (const float**)&p;
    for (int i = 0; i < 31; ++i) pp[i] = (const float*)d_in[i];
    p.out = (float GAS*)d_out; p.ws = (unsigned char GAS*)d_ws;
    if (hipMemsetAsync((char*)d_ws + WS_BAR, 0, WS_BAR_BYTES, stream) != hipSuccess) { fprintf(stderr, "kernel_launch: memset of the barrier words failed\n"); return; }
    void* args[] = {&p};
    hipError_t e = hipLaunchCooperativeKernel((const void*)mega_fwd, dim3(grid), dim3(512), args, LDS_BYTES, stream);
    if (e != hipSuccess) fprintf(stderr, "cooperative launch failed: %s (grid %d)\n", hipGetErrorString(e), grid);
}
```

```cpp
#include <hip/hip_runtime.h>
#include <hip/hip_cooperative_groups.h>
#include <cstdio>
#include <cstdint>
namespace cg = cooperative_groups;

#define LAS __attribute__((address_space(3)))
typedef unsigned short bf16_t;
typedef short bf16x8 __attribute__((ext_vector_type(8)));
typedef float f32x4 __attribute__((ext_vector_type(4)));
typedef float f32x2 __attribute__((ext_vector_type(2)));
typedef unsigned u32x4 __attribute__((ext_vector_type(4)));
typedef unsigned u32x2 __attribute__((ext_vector_type(2)));

constexpr int NB = 16, SEQ = 4096, DM = 1024, M = NB * SEQ, NL = 4;
constexpr int RW = 512, INC = 4864, RWC = 1792, DFF = 4096, NMOD = 6 * DM;
constexpr size_t U = 64ull << 20;
constexpr size_t O_IN = 0, O_LORA = O_IN + 4864ull * 1024, O_V12 = O_LORA + 1536ull * 256, O_WS = O_V12 + 512ull * 512,
                 O_BR1 = O_WS + 4ull * 128 * 128, O_BR2 = O_BR1 + 1024ull * 512, O_OUT = O_BR2 + 1024ull * 512,
                 O_FF1 = O_OUT + 1024ull * 1024, O_FF2 = O_FF1 + 4096ull * 1024, LW = O_FF2 + 1024ull * 4096;
constexpr size_t WS_BAR = (125ull << 20) + (512ull << 10), WS_BAR_BYTES = 16384;
constexpr size_t WS_MOD = 124ull << 20, WS_CB = 126ull << 20;
static_assert(LW * 2 * NL <= WS_MOD, "weights fit");
constexpr size_t WS_VF = 2 * U, WS_G = 3 * U, WS_PGM = 7 * U, WS_PRW = 9 * U, WS_LIN = 12 * U + U / 2, WS_R = 13 * U, WS_K0 = 14 * U,
                 WS_V0 = 15 * U, WS_YRW = 15 * U, WS_OMD = 9 * U, WS_ASIG = 10 * U, WS_GT = 11 * U, WS_MGF = 9 * U, WS_MG = 13 * U,
                 WS_H = 13 * U, WS_FH = 3 * U, WS_END = 16 * U;
static_assert(WS_ASIG == WS_OMD + U && WS_GT == WS_OMD + 2 * U, "EpiLora output spacing");
constexpr int LDS_BYTES = 135168;

#define GAS __attribute__((address_space(1)))
typedef const float GAS* gcf_t;
struct Params {
    gcf_t x, c, w_ada, b_ada, norm1_g, norm2_g, w_in, mu_shift, w0_decay, w2_decay, a0, w2_aaa, w2_gate, k_k, k_a, r_k,
        gn_w, gn_b, v0_res, w1_res, w2_res, ln_w, ln_b, w_sp, b_sp, w_br_rw, w_br_gm, w_out, w_ff1, w_ff2, final_g;
    float GAS* out; unsigned char GAS* ws;
};

#define GP(ptr_) ((const float*)(ptr_))
__device__ __forceinline__ float bflo(unsigned w) { return __builtin_bit_cast(float, w << 16); }
__device__ __forceinline__ float bfhi(unsigned w) { return __builtin_bit_cast(float, w & 0xffff0000u); }
__device__ __forceinline__ float bf1(bf16_t v) { return __builtin_bit_cast(float, (unsigned)v << 16); }
__device__ __forceinline__ unsigned f2bf(float f) { unsigned u = __builtin_bit_cast(unsigned, f); return (u + 0x7fffu + ((u >> 16) & 1u)) >> 16; }
typedef __bf16 bf16x2_t __attribute__((ext_vector_type(2)));
__device__ __forceinline__ unsigned pk2(float lo, float hi) { const f32x2 v = {lo, hi}; const bf16x2_t b = __builtin_convertvector(v, bf16x2_t); return __builtin_bit_cast(unsigned, b); }
__device__ __forceinline__ float rcpf_(float x) { return __builtin_amdgcn_rcpf(x); }
__device__ __forceinline__ float sigmoidf_(float x) { return rcpf_(1.f + __expf(-x)); }
__device__ __forceinline__ float tanhf_(float x) { return 1.f - 2.f * rcpf_(__expf(2.f * x) + 1.f); }
#define DPP_ADD(x, ctrl) ((x) + __builtin_bit_cast(float, __builtin_amdgcn_update_dpp(0, __builtin_bit_cast(int, (x)), (ctrl), 0xF, 0xF, true)))
__device__ __forceinline__ float red8(float x) { x = DPP_ADD(x, 0xB1); x = DPP_ADD(x, 0x4E); x = DPP_ADD(x, 0x141); return x; }
__device__ __forceinline__ float row_sum16(float x) { x = red8(x); x = DPP_ADD(x, 0x140); return x; }
__device__ __forceinline__ float half_sum(float v) {
    v = row_sum16(v);
    return v + __builtin_bit_cast(float, __builtin_amdgcn_ds_swizzle(__builtin_bit_cast(int, v), 0x401F));
}
__device__ __forceinline__ float wave_sum(float v) {
    v = half_sum(v);
    return __builtin_bit_cast(float, __builtin_amdgcn_readlane(__builtin_bit_cast(int, v), 0)) + __builtin_bit_cast(float, __builtin_amdgcn_readlane(__builtin_bit_cast(int, v), 32));
}
__device__ __forceinline__ int opaque_tid() { int t = threadIdx.x; asm volatile("" : "+v"(t)); return t; }
__device__ __forceinline__ const struct Params* opaque_params() { const struct Params* q = (const struct Params*)__builtin_amdgcn_kernarg_segment_ptr(); asm volatile("" : "+s"(q)); return q; }
__device__ __forceinline__ int opaque_bid() { int b = blockIdx.x; asm volatile("" : "+s"(b)); return b; }
__device__ __forceinline__ float omd_of(float d) {
    const float x = -d, sp = fmaxf(x, 0.f) + 0.69314718f * __builtin_amdgcn_logf(1.f + __builtin_amdgcn_exp2f(-1.44269504f * fabsf(x)));
    const float e = __builtin_amdgcn_exp2f((-sp - 0.5f) * 1.44269504f);
    const float poly = e * (1.f - e * (0.5f - e * (0.16666667f - e * (0.041666668f - e * 0.0083333333f))));
    const float big = 1.f - __builtin_amdgcn_exp2f(-1.44269504f * e);
    return e < 0.125f ? poly : big;
}
__device__ __forceinline__ float decay_of(float d) {
    const float sg = rcpf_(1.f + __builtin_amdgcn_exp2f(-1.44269504f * d));
    return __builtin_amdgcn_exp2f(-0.87503877f * sg);
}
__device__ __forceinline__ float gelu1(float v) {
    const float av = fabsf(v), t = rcpf_(av * 0.2316418882f + 1.0f);
    float q = t * 0.5307027145f + (-0.7265760135f); q = q * t + 0.7107068705f; q = q * t + (-0.142248368f); q = q * t + 0.127414796f; q = q * t;
    const float e = __builtin_amdgcn_exp2f((v * v) * (-0.72134752044f));
    const float m = v * (q * e);
    return v < 0.f ? m : v - m;
}

namespace pg8 {
constexpr int BM = 256, BK = 64, HALF = 128, HTB = HALF * BK * 2, STAGE_BYTES = 8 * HTB, NXCD = 8, WGM = 8;
__host__ __device__ __forceinline__ int lds_byte(int r, int c) { const int st = (r >> 4) * 2 + (c >> 5), rr = r & 15, cc = c & 31, ob = rr * 64 + cc * 2; return st * 1024 + (ob ^ (((ob >> 9) & 1) << 5)); }
__host__ __device__ __forceinline__ void stage_rc(int b, int& R, int& C) { const int st = b / 1024, sb = b % 1024, swz = sb ^ (((sb >> 9) & 1) << 5); R = (st >> 1) * 16 + swz / 64; C = (st & 1) * 32 + (swz % 64) / 2; }
__host__ __device__ __forceinline__ int perm32(int rho) { const int n = rho >> 4, i = rho & 15; return 8 * (i >> 2) + 4 * n + (i & 3); }

struct Unit { int pm, pn; };
__device__ __forceinline__ const char* uni(const char* p) { unsigned lo = __builtin_amdgcn_readfirstlane((unsigned)(size_t)p), hi = __builtin_amdgcn_readfirstlane((unsigned)((size_t)p >> 32));
    asm volatile("s_nop 4" : "+s"(lo), "+s"(hi));
    return (const char*)(((size_t)hi << 32) | (size_t)lo); }
struct Gemm { const bf16_t* A; const bf16_t* Bt; int lda, ldb, M, N, K; int kpn = 1 << 30, koff = 0; };

struct StaticOrder {
    int nM, nN, nwg, G, c;
    __device__ void init(int M_, int N_, int G_, int c_) { nM = M_ / BM; nN = N_ / BM; nwg = nM * nN; G = G_; c = c_; }
    __device__ bool next(int i, Unit& u) const {
        const long Lx = (long)i * G + c; if (Lx >= nwg) return false;
        int wgid = (int)Lx; { const int q = nwg / NXCD, r = nwg % NXCD, xcd = wgid % NXCD, off = wgid / NXCD; wgid = (xcd < r ? xcd * (q + 1) : r * (q + 1) + (xcd - r) * q) + off; }
        const int nig = WGM * nN, gid = wgid / nig, fm = gid * WGM, gsz = (nM - fm) < WGM ? (nM - fm) : WGM;
        u.pm = fm + ((wgid % nig) % gsz); u.pn = (wgid % nig) / gsz; return true;
    }
};

template <class Epi, bool ALIGN_EPI, bool MID = false>
__device__ __forceinline__ void gemm_phase(LAS unsigned char* lds, const Gemm g, const StaticOrder& S, const Epi& E) {
    const int tid = opaque_tid(), wid = __builtin_amdgcn_readfirstlane(tid >> 6), lane = tid & 63, wr = wid >> 2, wc = wid & 3, fr = lane & 15, fq = lane >> 4;
    const int K = g.K, nt = K / BK;
    unsigned voffA, voffB;
    { int R, C; stage_rc(tid * 16, R, C); const int Rb = (R & ~31) + perm32(R & 31);
      voffA = (unsigned)(R * g.lda + C) * 2u; voffB = (unsigned)(Rb * g.ldb + C) * 2u; }
    const size_t kstep = (size_t)(BK * 2);
    const size_t hstepA = (size_t)HALF * g.lda * 2, hstepB = (size_t)HALF * g.ldb * 2;
    const size_t tstepA = 2 * hstepA, tstepB = 2 * hstepB;
    const size_t pstepA = hstepA >> 1, pstepB = hstepB >> 1;
    const unsigned ldsbase = (unsigned)(size_t)lds + (unsigned)wid * 1024u;
    const int aoff = lds_byte(wr * 64 + fr, fq * 8), boff = lds_byte(wc * 32 + fr, fq * 8);
#define PG8_SA(b, h) (((b) * 2 + (h)) * HTB)
#define PG8_SB(b, h) ((4 + (b) * 2 + (h)) * HTB)
#define PG8_STAGE_(bufoff, gbase, voff, pstep) do { const char* _g0 = (const char*)(gbase); const char* _g1 = _g0 + (pstep); const unsigned _l0 = ldsbase + (unsigned)(bufoff), _l1 = _l0 + 8192u; \
        asm volatile("s_mov_b32 m0, %2\n\ts_nop 0\n\tglobal_load_lds_dwordx4 %0, %1" :: "v"(voff), "s"(_g0), "s"(_l0) : "memory"); \
        asm volatile("s_mov_b32 m0, %2\n\ts_nop 0\n\tglobal_load_lds_dwordx4 %0, %1" :: "v"(voff), "s"(_g1), "s"(_l1) : "memory"); } while (0)
#define PG8_STAGE(bufoff, gbase, voff) PG8_STAGE_(bufoff, gbase, voff, (&(voff) == &voffA) ? pstepA : pstepB)
#define PG8_LDA(dst, b, h) do { _Pragma("unroll") for (int m = 0; m < 4; ++m) _Pragma("unroll") for (int k = 0; k < 2; ++k) dst[m][k] = *(const LAS bf16x8*)(lds + PG8_SA(b, h) + aoff + m * 2048 + k * 1024); } while (0)
#define PG8_LDB(dst, b, h) do { _Pragma("unroll") for (int n = 0; n < 2; ++n) _Pragma("unroll") for (int k = 0; k < 2; ++k) dst[n][k] = *(const LAS bf16x8*)(lds + PG8_SB(b, h) + boff + n * 2048 + k * 1024); } while (0)
#define PG8_MMA(ai, bj, At, Bt) do { __builtin_amdgcn_s_setprio(1); _Pragma("unroll") for (int m = 0; m < 4; ++m) _Pragma("unroll") for (int n = 0; n < 2; ++n) _Pragma("unroll") for (int k = 0; k < 2; ++k) \
        acc[ai][bj][m][n] = __builtin_amdgcn_mfma_f32_16x16x32_bf16(Bt[n][k], At[m][k], acc[ai][bj][m][n], 0, 0, 0); __builtin_amdgcn_s_setprio(0); } while (0)
#define PG8_WAIT_V(n) asm volatile("s_waitcnt vmcnt(" #n ")" ::: "memory")
#define PG8_WAIT_L(n) asm volatile("s_waitcnt lgkmcnt(" #n ")" ::: "memory")
#define PG8_BAR __builtin_amdgcn_s_barrier()
#define PG8_SCHED __builtin_amdgcn_sched_barrier(0)
    Unit cur, nxt; int ui = 0;
    if (!S.next(0, cur)) return;
    f32x4 acc[2][2][4][2];
#pragma unroll
    for (int a = 0; a < 2; ++a)
#pragma unroll
        for (int b = 0; b < 2; ++b)
#pragma unroll
            for (int m = 0; m < 4; ++m)
#pragma unroll
                for (int n = 0; n < 2; ++n) acc[a][b][m][n] = (f32x4){0.f, 0.f, 0.f, 0.f};
    bf16x8 At[4][2], B0[2][2], B1[2][2];
    const size_t kob0 = (cur.pn >= g.kpn) ? (size_t)g.koff * 2 : 0;
    const char* cA = uni((const char*)g.A + (size_t)cur.pm * tstepA + kob0); const char* cB = uni((const char*)g.Bt + (size_t)cur.pn * tstepB + kob0);
    PG8_STAGE(PG8_SB(0, 0), cB, voffB); PG8_STAGE(PG8_SB(0, 1), cB + hstepB, voffB); PG8_STAGE(PG8_SA(0, 0), cA, voffA); PG8_STAGE(PG8_SA(0, 1), cA + hstepA, voffA);
    if (wr == 1) PG8_BAR;
    PG8_WAIT_V(2); PG8_BAR;
    PG8_STAGE(PG8_SB(1, 0), cB + kstep, voffB); PG8_STAGE(PG8_SA(1, 0), cA + kstep, voffA); PG8_STAGE(PG8_SB(1, 1), cB + hstepB + kstep, voffB);
    PG8_WAIT_V(6); PG8_BAR;
    for (;;) {
        const bool has_next = S.next(ui + 1, nxt);
        const size_t kob1 = (has_next && nxt.pn >= g.kpn) ? (size_t)g.koff * 2 : 0;
        const char* nA = uni(has_next ? (const char*)g.A + (size_t)nxt.pm * tstepA + kob1 : cA); const char* nB = uni(has_next ? (const char*)g.Bt + (size_t)nxt.pn * tstepB + kob1 : cB);
#pragma unroll 1
        for (int t = 0; t < nt; t += 2) {
            const bool last = (t == nt - 2);
            if constexpr (MID) { if (t == (nt >> 1)) E.mid(acc, cur, wr, wc, fr, fq); }
            const char* a1 = cA + (size_t)(t + 1) * kstep;
            const char* a2 = last ? nA : cA + (size_t)(t + 2) * kstep; const char* b2 = last ? nB : cB + (size_t)(t + 2) * kstep;
            const char* a3 = a2 + kstep; const char* b3 = b2 + kstep;
            PG8_LDB(B0, 0, 0); PG8_LDB(B1, 0, 1); PG8_SCHED; PG8_LDA(At, 0, 0); PG8_STAGE(PG8_SA(1, 1), a1 + hstepA, voffA);
            PG8_WAIT_V(8); PG8_WAIT_L(0); PG8_BAR; PG8_MMA(0, 0, At, B0); PG8_MMA(0, 1, At, B1); PG8_BAR; PG8_SCHED;
            PG8_LDA(At, 0, 1); PG8_STAGE(PG8_SB(0, 0), b2, voffB); PG8_STAGE(PG8_SB(0, 1), b2 + hstepB, voffB); PG8_STAGE(PG8_SA(0, 0), a2, voffA);
            PG8_WAIT_V(8); PG8_WAIT_L(0); PG8_BAR; PG8_MMA(1, 0, At, B0); PG8_MMA(1, 1, At, B1); PG8_BAR; PG8_SCHED;
            PG8_LDB(B0, 1, 0); PG8_LDB(B1, 1, 1); PG8_SCHED; PG8_LDA(At, 1, 0); PG8_STAGE(PG8_SA(0, 1), a2 + hstepA, voffA);
            PG8_WAIT_V(8); PG8_WAIT_L(0); PG8_BAR; PG8_MMA(0, 0, At, B0); PG8_MMA(0, 1, At, B1); PG8_BAR; PG8_SCHED;
            PG8_LDA(At, 1, 1); PG8_STAGE(PG8_SB(1, 0), b3, voffB); PG8_STAGE(PG8_SB(1, 1), b3 + hstepB, voffB); PG8_STAGE(PG8_SA(1, 0), a3, voffA);
            PG8_WAIT_V(8); PG8_WAIT_L(0); PG8_BAR; PG8_MMA(1, 0, At, B0); PG8_MMA(1, 1, At, B1); PG8_BAR; PG8_SCHED;
        }
        if constexpr (ALIGN_EPI) { if (wr == 0) PG8_BAR; }
        E(acc, cur, wr, wc, fr, fq);
        if (!has_next) break;
#pragma unroll
        for (int a = 0; a < 2; ++a)
#pragma unroll
            for (int b = 0; b < 2; ++b)
#pragma unroll
                for (int m = 0; m < 4; ++m)
#pragma unroll
                    for (int n = 0; n < 2; ++n) acc[a][b][m][n] = (f32x4){0.f, 0.f, 0.f, 0.f};
        cur = nxt; cA = nA; cB = nB; ++ui;
        if constexpr (ALIGN_EPI) { if (wr == 1) PG8_BAR; }
    }
    PG8_WAIT_V(0);
    if constexpr (!ALIGN_EPI) { if (wr == 0) PG8_BAR; }
    PG8_BAR;
#undef PG8_SA
#undef PG8_SB
#undef PG8_STAGE
#undef PG8_STAGE_
#undef PG8_LDA
#undef PG8_LDB
#undef PG8_MMA
#undef PG8_WAIT_V
#undef PG8_WAIT_L
#undef PG8_BAR
#undef PG8_SCHED
}

#define EPI_LOOP_BEGIN \
    const int row0 = u.pm * BM + wr * 64 + fr, colb = u.pn * BM + wc * 32 + 8 * fq; \
    _Pragma("unroll") for (int ai = 0; ai < 2; ++ai) _Pragma("unroll") for (int m = 0; m < 4; ++m) { const size_t row = (size_t)(row0 + ai * HALF + m * 16); \
    _Pragma("unroll") for (int bj = 0; bj < 2; ++bj) { const int col = colb + bj * HALF; f32x4 v0 = acc[ai][bj][m][0], v1 = acc[ai][bj][m][1];
#define EPI_LOOP_END } }
#define EPI_SIG typedef const f32x4 (&AccT)[2][2][4][2]; __device__ __forceinline__ void operator()(AccT acc, const Unit& u, int wr, int wc, int fr, int fq) const

__device__ __forceinline__ void st_bf16x8(bf16_t* p, f32x4 v0, f32x4 v1) { u32x4 w; w.x = pk2(v0[0], v0[1]); w.y = pk2(v0[2], v0[3]); w.z = pk2(v1[0], v1[1]); w.w = pk2(v1[2], v1[3]); *(u32x4*)p = w; }
__device__ __forceinline__ void ld_bf16x8(const bf16_t* p, f32x4& v0, f32x4& v1) { const u32x4 w = *(const u32x4*)p; v0 = (f32x4){bflo(w.x), bfhi(w.x), bflo(w.y), bfhi(w.y)}; v1 = (f32x4){bflo(w.z), bfhi(w.z), bflo(w.w), bfhi(w.w)}; }

struct EpiInproj { bf16_t *Prw, *Pgm, *G; EPI_SIG {
    bf16_t* base; int ld, cofs; bool sig = false;
    if (u.pn < 7) { base = Prw; ld = RWC; cofs = 0; } else if (u.pn < 11) { base = Pgm; ld = 1024; cofs = 7 * BM; } else { base = G; ld = 2048; cofs = 11 * BM; sig = true; }
    EPI_LOOP_BEGIN
        if (sig) {
#pragma unroll
            for (int j = 0; j < 4; ++j) { v0[j] = sigmoidf_(v0[j]); v1[j] = sigmoidf_(v1[j]); } }
        st_bf16x8(base + row * ld + (col - cofs), v0, v1);
    EPI_LOOP_END
} };
struct EpiLora { bf16_t* OUT; EPI_SIG {
    const int kind = u.pn >> 1; bf16_t* base = OUT + (size_t)kind * (U / 2) - kind * 512;
    EPI_LOOP_BEGIN
        st_bf16x8(base + row * 512 + col, v0, v1);
    EPI_LOOP_END
} };
struct EpiVres { const bf16_t *V0, *VF; bf16_t* V; int ldv; const float* v0res; EPI_SIG {
    EPI_LOOP_BEGIN
        f32x4 a0, a1, f0, f1; ld_bf16x8(V0 + row * 512 + col, a0, a1); ld_bf16x8(VF + row * 512 + col, f0, f1);
        const f32x4 b0 = *(const f32x4*)(v0res + col), b1 = *(const f32x4*)(v0res + col + 4);
#pragma unroll
        for (int j = 0; j < 4; ++j) { v0[j] = a0[j] + (f0[j] - a0[j]) * sigmoidf_(b0[j] + v0[j]); v1[j] = a1[j] + (f1[j] - a1[j]) * sigmoidf_(b1[j] + v1[j]); }
        st_bf16x8(V + row * ldv + col, v0, v1);
    EPI_LOOP_END
} };
struct EpiMergeF { const bf16_t* G; bf16_t* MG;
    __device__ __forceinline__ void mid(f32x4 (&acc)[2][2][4][2], const Unit& u, int wr, int wc, int fr, int fq) const {
        const int row0 = u.pm * BM + wr * 64 + fr, colb = u.pn * BM + wc * 32 + 8 * fq;
#pragma unroll
        for (int ai = 0; ai < 2; ++ai)
#pragma unroll
            for (int m = 0; m < 4; ++m) { const size_t row = (size_t)(row0 + ai * HALF + m * 16);
#pragma unroll
                for (int bj = 0; bj < 2; ++bj) { const int col = colb + bj * HALF;
                    f32x4 ga0, ga1, gb0, gb1; ld_bf16x8(G + row * 2048 + col, ga0, ga1); ld_bf16x8(G + row * 2048 + 1024 + col, gb0, gb1);
#pragma unroll
                    for (int j = 0; j < 4; ++j) { acc[ai][bj][m][0][j] *= gb0[j] * rcpf_(ga0[j]); acc[ai][bj][m][1][j] *= gb1[j] * rcpf_(ga1[j]); } }
                }
    }
    EPI_SIG {
    EPI_LOOP_BEGIN
        f32x4 g0, g1; ld_bf16x8(G + row * 2048 + col, g0, g1);
        st_bf16x8(MG + row * 1024 + col, g0 * v0, g1 * v1);
    EPI_LOOP_END
} };
struct EpiResid { const float* xin; float* xout; const float* gate; EPI_SIG {
    const float* gb = gate + (size_t)(u.pm >> 4) * NMOD;
    EPI_LOOP_BEGIN
        const f32x4 g0 = *(const f32x4*)(gb + col), g1 = *(const f32x4*)(gb + col + 4);
        const f32x4 x0 = *(const f32x4*)(xin + row * 1024 + col), x1 = *(const f32x4*)(xin + row * 1024 + col + 4);
        *(f32x4*)(xout + row * 1024 + col) = x0 + g0 * v0; *(f32x4*)(xout + row * 1024 + col + 4) = x1 + g1 * v1;
    EPI_LOOP_END
} };
struct EpiFF1 { bf16_t* FH; EPI_SIG {
    EPI_LOOP_BEGIN
#pragma unroll
        for (int j = 0; j < 4; ++j) { float a = fmaxf(v0[j], 0.f), b = fmaxf(v1[j], 0.f); v0[j] = a * a; v1[j] = b * b; }
        st_bf16x8(FH + row * 4096 + col, v0, v1);
    EPI_LOOP_END
} };
}

__device__ __forceinline__ void transpose_item(const float* W, int K, int N, bf16_t* WT, int ldo, LAS float* scr, int item, int lane) {
    const int nblk = N / 32, kb = item / nblk, nb = item % nblk, k0 = 64 * kb, n0 = 32 * nb;
    float tv[32];
#pragma unroll
    for (int i = 0; i < 32; ++i) tv[i] = W[(size_t)(k0 + 2 * i + (lane >> 5)) * N + n0 + (lane & 31)];
#pragma unroll
    for (int i = 0; i < 32; ++i) scr[(2 * i + (lane >> 5)) * 33 + (lane & 31)] = tv[i];
    asm volatile("s_waitcnt lgkmcnt(0)" ::: "memory");
    const int c = lane & 7;
#pragma unroll
    for (int j = 0; j < 4; ++j) { const int n = (lane >> 3) + 8 * j; const LAS float* s = scr + (8 * c) * 33 + n;
        u32x4 o; o.x = f2bf(s[0 * 33]) | (f2bf(s[1 * 33]) << 16); o.y = f2bf(s[2 * 33]) | (f2bf(s[3 * 33]) << 16); o.z = f2bf(s[4 * 33]) | (f2bf(s[5 * 33]) << 16); o.w = f2bf(s[6 * 33]) | (f2bf(s[7 * 33]) << 16);
        *(u32x4*)(WT + (size_t)(n0 + n) * ldo + k0 + 8 * c) = o; }
    asm volatile("s_waitcnt lgkmcnt(0)" ::: "memory");
}

__device__ __forceinline__ void prologue(const Params& p, LAS unsigned char* lds, int tid, int lane, int wave, int bid, int G) {
    bf16_t* Wb = (bf16_t*)p.ws;
    {
        LAS float* scr = (LAS float*)(lds + wave * 16384);
        const int gw = bid * 8 + wave, NGW = G * 8;
        constexpr int I_IN = 16 * 152, I_BR = 8 * 32, I_OUT = 16 * 32, I_FF1 = 16 * 128, I_FF2 = 64 * 32, I_L = I_IN + 2 * I_BR + I_OUT + I_FF1 + I_FF2;
        for (int it = gw; it < NL * I_L; it += NGW) {
            const int l = it / I_L; int r = it % I_L; bf16_t* wl = Wb + (size_t)l * LW;
            if (r < I_IN) { transpose_item(GP(p.w_in) + (size_t)l * 1024 * 4864, 1024, 4864, wl + O_IN, 1024, scr, r, lane); continue; } r -= I_IN;
            if (r < I_BR) { transpose_item(GP(p.w_br_rw) + (size_t)l * 512 * 1024, 512, 1024, wl + O_BR1 + 512, 1024, scr, r, lane); continue; } r -= I_BR;
            if (r < I_BR) { transpose_item(GP(p.w_br_gm) + (size_t)l * 512 * 1024, 512, 1024, wl + O_BR1, 1024, scr, r, lane); continue; } r -= I_BR;
            if (r < I_OUT) { transpose_item(GP(p.w_out) + (size_t)l * 1024 * 1024, 1024, 1024, wl + O_OUT, 1024, scr, r, lane); continue; } r -= I_OUT;
            if (r < I_FF1) { transpose_item(GP(p.w_ff1) + (size_t)l * 1024 * 4096, 1024, 4096, wl + O_FF1, 1024, scr, r, lane); continue; } r -= I_FF1;
            transpose_item(GP(p.w_ff2) + (size_t)l * 4096 * 1024, 4096, 1024, wl + O_FF2, 4096, scr, r, lane);
        }
    }
    {
        const int gt = bid * 512 + tid, NT = G * 512;
        for (int idx = gt; idx < NL * 1536 * 256; idx += NT) {
            const int l = idx / (1536 * 256), r = idx % (1536 * 256), n = r >> 8, k = r & 255; float v = 0.f;
            if (n < 512) { if (k < 64) v = GP(p.w2_decay)[((size_t)l * 64 + k) * 512 + n]; }
            else if (n < 1024) { if (k >= 64 && k < 128) v = GP(p.w2_aaa)[((size_t)l * 64 + (k - 64)) * 512 + (n - 512)]; }
            else { if (k >= 128) v = GP(p.w2_gate)[((size_t)l * 128 + (k - 128)) * 512 + (n - 1024)]; }
            Wb[(size_t)l * LW + O_LORA + r] = (bf16_t)f2bf(v);
        }
        for (int idx = gt; idx < (NL - 1) * 512 * 512; idx += NT) {
            const int l1 = idx / (512 * 512), r = idx % (512 * 512), n = r >> 9, k = r & 511; float s = 0.f;
            const float* w1 = GP(p.w1_res) + ((size_t)l1 * 512 + k) * 32; const float* w2 = GP(p.w2_res) + (size_t)l1 * 32 * 512 + n;
            float w1v[32], w2v[32];
#pragma unroll
            for (int q = 0; q < 32; ++q) { w1v[q] = w1[q]; w2v[q] = w2[(size_t)q * 512]; }
#pragma unroll
            for (int q = 0; q < 32; ++q) s += w1v[q] * w2v[q];
            Wb[(size_t)(l1 + 1) * LW + O_V12 + r] = (bf16_t)f2bf(s);
        }
        for (int idx = gt; idx < NL * 4 * 128 * 128; idx += NT) {
            const int l = idx / 65536, r = idx % 65536, i = (r >> 7) & 127, j = r & 127;
            const float v = ((i >> 6) >= (j >> 6)) ? GP(p.w_sp)[idx] : 0.f;
            Wb[(size_t)l * LW + O_WS + r] = (bf16_t)f2bf(v);
        }
    }
    __syncthreads();
    {
        LAS float* cact = (LAS float*)lds; LAS float* part = (LAS float*)(lds + 65536);
        for (int i = tid; i < NB * DM; i += 512) { const float v = GP(p.c)[i]; cact[i] = v * sigmoidf_(v); }
        __syncthreads();
        float* mod = (float*)(p.ws + WS_MOD);
        const int ks = tid >> 6, nl = tid & 63;
        for (int it = bid; it < NL * 96; it += G) {
            const int l = it / 96, n0 = (it % 96) * 64;
            float a[16];
#pragma unroll
            for (int b = 0; b < 16; ++b) a[b] = 0.f;
            const float* wp = GP(p.w_ada) + ((size_t)l * 1024 + ks * 128) * NMOD + n0 + nl;
            for (int k0 = 0; k0 < 128; k0 += 16) { float w[16];
#pragma unroll
                for (int kk = 0; kk < 16; ++kk) w[kk] = wp[(size_t)(k0 + kk) * NMOD];
#pragma unroll
                for (int kk = 0; kk < 16; ++kk)
#pragma unroll
                    for (int b = 0; b < 16; ++b) a[b] += cact[b * 1024 + ks * 128 + k0 + kk] * w[kk]; }
#pragma unroll
            for (int b = 0; b < 16; ++b) part[(ks * 16 + b) * 64 + nl] = a[b];
            __syncthreads();
#pragma unroll
            for (int e = 0; e < 2; ++e) { const int o = tid + 512 * e, b = o >> 6, n2 = o & 63; float s = GP(p.b_ada)[(size_t)l * NMOD + n0 + n2];
#pragma unroll
                for (int q = 0; q < 8; ++q) s += part[(q * 16 + b) * 64 + n2];
                mod[((size_t)l * NB + b) * NMOD + n0 + n2] = s; }
            __syncthreads();
        }
    }
}

__device__ __forceinline__ void norm_phase(const float* __restrict__ x, const float* __restrict__ gain, const float* __restrict__ modl, int shofs, bf16_t* __restrict__ H, int gw, int NGW, int lane) {
    for (int m0 = gw; m0 < M; m0 += 4 * NGW) {
        f32x4 v[4][4]; float s[4];
#pragma unroll
        for (int r = 0; r < 4; ++r) { const f32x4* xr = (const f32x4*)(x + (size_t)(m0 + r * NGW) * DM) + lane;
#pragma unroll
            for (int j = 0; j < 4; ++j) v[r][j] = xr[64 * j]; }
#pragma unroll
        for (int r = 0; r < 4; ++r) { s[r] = 0.f;
#pragma unroll
            for (int j = 0; j < 4; ++j) s[r] += (v[r][j].x * v[r][j].x + v[r][j].y * v[r][j].y) + (v[r][j].z * v[r][j].z + v[r][j].w * v[r][j].w); }
#pragma unroll
        for (int r = 0; r < 4; ++r) { const int m = m0 + r * NGW;
            const float rstd = rsqrtf(wave_sum(s[r]) * (1.f / DM) + 1e-6f);
            const float* mb = modl + (size_t)(m >> 12) * NMOD + shofs;
            u32x2* o = (u32x2*)(H + (size_t)m * DM) + lane;
#pragma unroll
            for (int j = 0; j < 4; ++j) { const int col = 4 * lane + 256 * j;
                const f32x4 g4 = *(const f32x4*)(gain + col), sh = *(const f32x4*)(mb + col), sc = *(const f32x4*)(mb + 1024 + col);
                const f32x4 h = (v[r][j] * rstd * g4) * (sc + 1.f) + sh;
                u32x2 w; w.x = pk2(h.x, h.y); w.y = pk2(h.z, h.w); o[64 * j] = w; } }
    }
}
__device__ __forceinline__ void final_norm(float* x, const float* __restrict__ gain, int gw, int NGW, int lane) {
    for (int m0 = gw; m0 < M; m0 += 4 * NGW) {
        f32x4 v[4][4]; float s[4];
#pragma unroll
        for (int r = 0; r < 4; ++r) { const f32x4* xr = (const f32x4*)(x + (size_t)(m0 + r * NGW) * DM) + lane;
#pragma unroll
            for (int j = 0; j < 4; ++j) v[r][j] = xr[64 * j]; }
#pragma unroll
        for (int r = 0; r < 4; ++r) { s[r] = 0.f;
#pragma unroll
            for (int j = 0; j < 4; ++j) s[r] += (v[r][j].x * v[r][j].x + v[r][j].y * v[r][j].y) + (v[r][j].z * v[r][j].z + v[r][j].w * v[r][j].w); }
#pragma unroll
        for (int r = 0; r < 4; ++r) { f32x4* xr = (f32x4*)(x + (size_t)(m0 + r * NGW) * DM) + lane;
            const float rstd = rsqrtf(wave_sum(s[r]) * (1.f / DM) + 1e-6f);
#pragma unroll
            for (int j = 0; j < 4; ++j) { const f32x4 g4 = *(const f32x4*)(gain + 4 * lane + 256 * j); xr[64 * j] = v[r][j] * rstd * g4; } }
    }
}

__device__ __forceinline__ void prep1_phase(const bf16_t* __restrict__ Prw, const float* __restrict__ mu, bf16_t* __restrict__ R, bf16_t* __restrict__ K0, bf16_t* __restrict__ V0, bf16_t* __restrict__ LIN, int gt, int NT) {
    constexpr int CH = RWC / 8;
    for (int idx0 = gt; idx0 < M * CH; idx0 += 8 * NT) {
        u32x4 cw[8], pw[8]; f32x4 m0[8], m1[8];
#pragma unroll
        for (int u = 0; u < 8; ++u) { const int idx = idx0 + u * NT, m = idx / CH, col = (idx % CH) * 8;
            cw[u] = *(const u32x4*)(Prw + (size_t)m * RWC + col);
            pw[u] = ((m & (SEQ - 1)) != 0) ? *(const u32x4*)(Prw + (size_t)(m - 1) * RWC + col) : (u32x4){0u, 0u, 0u, 0u};
            m0[u] = *(const f32x4*)(mu + col); m1[u] = *(const f32x4*)(mu + col + 4); }
#pragma unroll
        for (int u = 0; u < 8; ++u) { const int idx = idx0 + u * NT, m = idx / CH, col = (idx % CH) * 8;
            const f32x4 c0 = (f32x4){bflo(cw[u].x), bfhi(cw[u].x), bflo(cw[u].y), bfhi(cw[u].y)}, c1 = (f32x4){bflo(cw[u].z), bfhi(cw[u].z), bflo(cw[u].w), bfhi(cw[u].w)};
            const f32x4 p0 = (f32x4){bflo(pw[u].x), bfhi(pw[u].x), bflo(pw[u].y), bfhi(pw[u].y)}, p1 = (f32x4){bflo(pw[u].z), bfhi(pw[u].z), bflo(pw[u].w), bfhi(pw[u].w)};
            f32x4 x0 = c0 + (p0 - c0) * m0[u], x1 = c1 + (p1 - c1) * m1[u];
            bf16_t* dst;
            if (col < 512) dst = R + (size_t)m * 512 + col;
            else if (col < 1024) dst = K0 + (size_t)m * 512 + (col - 512);
            else if (col < 1536) dst = V0 + (size_t)m * 512 + (col - 1024);
            else { dst = LIN + (size_t)m * 256 + (col - 1536);
                if (col < 1600) {
#pragma unroll
                    for (int j = 0; j < 4; ++j) { x0[j] = tanhf_(x0[j]); x1[j] = tanhf_(x1[j]); } }
                else if (col >= 1664) {
#pragma unroll
                    for (int j = 0; j < 4; ++j) { x0[j] = sigmoidf_(x0[j]); x1[j] = sigmoidf_(x1[j]); } } }
            pg8::st_bf16x8(dst, x0, x1); }
    }
}

__device__ __forceinline__ void gmlp_item(LAS unsigned char* lds, bf16_t* Pgm, bf16_t* Yo, const bf16_t* __restrict__ Wsm, const float* __restrict__ lnw, const float* __restrict__ lnb, const float* __restrict__ bsp, int item, int tid, int lane, int wave) {
    LAS float* stats = (LAS float*)lds;
    LAS bf16_t* Vs = (LAS bf16_t*)(lds + 1024);
    constexpr int VP = 130;
    const size_t m0 = (size_t)item * 128;
#pragma unroll
    for (int hb = 0; hb < 2; ++hb) {
        u32x4 raw[8];
#pragma unroll
        for (int e = 0; e < 8; ++e) raw[e] = *(const u32x4*)(Pgm + (m0 + wave * 16 + hb * 8 + e) * 1024 + 512 + lane * 8);
#pragma unroll
        for (int e = 0; e < 8; ++e) { const int tk = wave * 16 + hb * 8 + e; float s = 0.f, ss = 0.f;
            const unsigned w4[4] = {raw[e].x, raw[e].y, raw[e].z, raw[e].w};
#pragma unroll
            for (int j = 0; j < 4; ++j) { const float g0 = gelu1(bflo(w4[j])), g1 = gelu1(bfhi(w4[j])); s += g0 + g1; ss += g0 * g0 + g1 * g1; }
            s = wave_sum(s); ss = wave_sum(ss);
            const float mean = s * (1.f / 512.f), var = fmaxf(ss * (1.f / 512.f) - mean * mean, 0.f);
            if (lane == 0) { stats[tk * 2] = mean; stats[tk * 2 + 1] = rsqrtf(var + 1e-5f); } }
    }
    __syncthreads();
    const int fr = lane & 15, fq = lane >> 4;
    const int i = 16 * wave + fr;
#pragma unroll 1
    for (int g = 0; g < 4; ++g) {
        u32x4 vraw[4]; bf16x8 af[4]; u32x2 uw[8];
#pragma unroll
        for (int it = 0; it < 4; ++it) { const int q = tid + 512 * it, j = q >> 4, dc = q & 15; vraw[it] = *(const u32x4*)(Pgm + (m0 + j) * 1024 + 512 + g * 128 + dc * 8); }
#pragma unroll
        for (int kc = 0; kc < 4; ++kc) af[kc] = *(const bf16x8*)(Wsm + ((size_t)g * 128 + i) * 128 + kc * 32 + fq * 8);
        bf16_t* urow = Pgm + (m0 + i) * 1024 + g * 128 + fq * 4;
#pragma unroll
        for (int dt = 0; dt < 8; ++dt) uw[dt] = *(const u32x2*)(urow + dt * 16);
        const float bs = bsp[g * 128 + i];
#pragma unroll
        for (int it = 0; it < 4; ++it) { const int q = tid + 512 * it, j = q >> 4, dc = q & 15;
            const float mean = stats[j * 2], rstd = stats[j * 2 + 1];
            const f32x4 w0 = *(const f32x4*)(lnw + g * 128 + dc * 8), w1 = *(const f32x4*)(lnw + g * 128 + dc * 8 + 4);
            const f32x4 b0 = *(const f32x4*)(lnb + g * 128 + dc * 8), b1 = *(const f32x4*)(lnb + g * 128 + dc * 8 + 4);
            f32x4 a0 = (f32x4){bflo(vraw[it].x), bfhi(vraw[it].x), bflo(vraw[it].y), bfhi(vraw[it].y)}, a1 = (f32x4){bflo(vraw[it].z), bfhi(vraw[it].z), bflo(vraw[it].w), bfhi(vraw[it].w)};
#pragma unroll
            for (int e = 0; e < 4; ++e) { a0[e] = (gelu1(a0[e]) - mean) * rstd * w0[e] + b0[e]; a1[e] = (gelu1(a1[e]) - mean) * rstd * w1[e] + b1[e]; }
            LAS unsigned* dst = (LAS unsigned*)(Vs + j * VP + dc * 8);
            dst[0] = pk2(a0[0], a0[1]); dst[1] = pk2(a0[2], a0[3]); dst[2] = pk2(a1[0], a1[1]); dst[3] = pk2(a1[2], a1[3]); }
        __syncthreads();
        f32x4 acc[8];
#pragma unroll
        for (int dt = 0; dt < 8; ++dt) { acc[dt] = (f32x4){0.f, 0.f, 0.f, 0.f};
#pragma unroll
            for (int kc = 0; kc < 4; ++kc) { bf16x8 bfv;
#pragma unroll
                for (int e = 0; e < 8; ++e) bfv[e] = (short)Vs[(kc * 32 + fq * 8 + e) * VP + dt * 16 + fr];
                acc[dt] = __builtin_amdgcn_mfma_f32_16x16x32_bf16(bfv, af[kc], acc[dt], 0, 0, 0); } }
#pragma unroll
        for (int dt = 0; dt < 8; ++dt) {
            const float y0 = gelu1(bflo(uw[dt].x)) * (acc[dt][0] + bs), y1 = gelu1(bfhi(uw[dt].x)) * (acc[dt][1] + bs), y2 = gelu1(bflo(uw[dt].y)) * (acc[dt][2] + bs), y3 = gelu1(bfhi(uw[dt].y)) * (acc[dt][3] + bs);
            u32x2 o; o.x = pk2(y0, y1); o.y = pk2(y2, y3); *(u32x2*)(Yo + (m0 + i) * 1024 + g * 128 + fq * 4 + dt * 16) = o; }
        __syncthreads();
    }
}

__device__ __forceinline__ void scan_phase(LAS unsigned char* lds, const bf16_t* __restrict__ R, const bf16_t* __restrict__ K0, const bf16_t* __restrict__ AS, const bf16_t* __restrict__ OMD, const bf16_t* __restrict__ V, int ldv,
                                           bf16_t* __restrict__ Y, float* __restrict__ CB, const float* k_k, const float* k_a, const float* r_k, const float* w0p, const float* a0p, int bid, int tid) {
    constexpr int CT = 32, VF32 = CT * 64, BUFF = 6 * VF32;
    LAS float* buf = (LAS float*)lds;
    LAS float* ybuf = (LAS float*)(lds + 2 * BUFF * 4);
    const int bh = bid >> 1, half = bid & 1, b = bh >> 3, h = bh & 7;
    const int lane = tid & 63, wave = __builtin_amdgcn_readfirstlane(tid >> 6);
    const size_t mrow0 = (size_t)b * SEQ;
    constexpr int NCH = SEQ / CT;
    if (wave >= 4) {
        const int lt = tid - 256, tt = lt >> 4, jg = lt & 15, jl = 4 * jg, colL = h * 64 + jl;
        const f32x4 kk4 = *(const f32x4*)(k_k + colL), ka4 = *(const f32x4*)(k_a + colL), rk4 = *(const f32x4*)(r_k + colL), wz4 = *(const f32x4*)(w0p + colL), az4 = *(const f32x4*)(a0p + colL);
        u32x2 Pr0, Pk0, Pa0, Po0, Pv0, Pr1, Pk1, Pa1, Po1, Pv1;
#define SCAN_LOAD1(c, tk, Pr, Pk, Pa, Po, Pv) do { const size_t m_ = mrow0 + (size_t)(c) * CT + (tk); \
        Pr = *(const u32x2*)(R + m_ * 512 + colL); Pk = *(const u32x2*)(K0 + m_ * 512 + colL); Pa = *(const u32x2*)(AS + m_ * 512 + colL); \
        Po = *(const u32x2*)(OMD + m_ * 512 + colL); Pv = *(const u32x2*)(V + m_ * (size_t)ldv + colL); } while (0)
#define SCAN_LOAD(c) do { SCAN_LOAD1(c, tt, Pr0, Pk0, Pa0, Po0, Pv0); SCAN_LOAD1(c, tt + 16, Pr1, Pk1, Pa1, Po1, Pv1); } while (0)
#define SCAN_FILL1(c, nb, tk, Pr, Pk, Pa, Po, Pv) do { LAS float* B_ = buf + (nb) * BUFF + (tk) * 64 + jl; \
        const f32x4 r4 = (f32x4){bflo(Pr.x), bfhi(Pr.x), bflo(Pr.y), bfhi(Pr.y)}, k4 = (f32x4){bflo(Pk.x), bfhi(Pk.x), bflo(Pk.y), bfhi(Pk.y)}; \
        const f32x4 al = (f32x4){bflo(Pa.x), bfhi(Pa.x), bflo(Pa.y), bfhi(Pa.y)}, ol = (f32x4){bflo(Po.x), bfhi(Po.x), bflo(Po.y), bfhi(Po.y)}; \
        f32x4 a4, w4; _Pragma("unroll") for (int e_ = 0; e_ < 4; ++e_) { a4[e_] = sigmoidf_(az4[e_] + al[e_]); w4[e_] = decay_of(wz4[e_] + ol[e_]); } \
        const f32x4 q4 = k4 * kk4; const float ssq = row_sum16((q4.x * q4.x + q4.y * q4.y) + (q4.z * q4.z + q4.w * q4.w)); const float inv = 1.f / fmaxf(sqrtf(ssq), 1e-12f); \
        const f32x4 n4 = q4 * inv; const f32x4 km4 = k4 * ((a4 - 1.f) * ka4 + 1.f); const f32x4 bo4 = r4 * km4 * rk4; \
        const float bon = row_sum16((bo4.x + bo4.y) + (bo4.z + bo4.w)); \
        *(LAS f32x4*)(B_ + 0 * VF32) = w4; *(LAS f32x4*)(B_ + 1 * VF32) = -n4; *(LAS f32x4*)(B_ + 2 * VF32) = n4 * a4; *(LAS f32x4*)(B_ + 3 * VF32) = km4; *(LAS f32x4*)(B_ + 4 * VF32) = r4; \
        *(LAS f32x4*)(B_ + 5 * VF32) = (f32x4){bflo(Pv.x), bfhi(Pv.x), bflo(Pv.y), bfhi(Pv.y)}; \
        if (half == 0 && jg == 0) CB[(mrow0 + (size_t)(c) * CT + (tk)) * 8 + h] = bon; } while (0)
#define SCAN_FILL(c, nb) do { SCAN_FILL1(c, nb, tt, Pr0, Pk0, Pa0, Po0, Pv0); SCAN_FILL1(c, nb, tt + 16, Pr1, Pk1, Pa1, Po1, Pv1); } while (0)
#define SCAN_WRITE(c, yb_) do { const int t2_ = lt >> 3, ip_ = lt & 7; const size_t m_ = mrow0 + (size_t)(c) * CT + t2_; \
        const f32x4 yy_ = *(const LAS f32x4*)((yb_) + t2_ * 32 + 4 * ip_); u32x2 o_; o_.x = pk2(yy_.x, yy_.y); o_.y = pk2(yy_.z, yy_.w); *(u32x2*)(Y + m_ * 512 + h * 64 + half * 32 + 4 * ip_) = o_; } while (0)
        SCAN_LOAD(0); SCAN_FILL(0, 0); SCAN_LOAD(1);
        __syncthreads();
#pragma unroll 1
        for (int c = 0; c < NCH; ++c) {
            const int cur = c & 1;
            if (c > 0) SCAN_WRITE(c - 1, ybuf + (cur ^ 1) * (CT * 32));
            if (c + 1 < NCH) { SCAN_FILL(c + 1, cur ^ 1); if (c + 2 < NCH) SCAN_LOAD(c + 2); }
            __syncthreads();
        }
        SCAN_WRITE(NCH - 1, ybuf + ((NCH - 1) & 1) * (CT * 32));
#undef SCAN_LOAD1
#undef SCAN_LOAD
#undef SCAN_FILL1
#undef SCAN_FILL
#undef SCAN_WRITE
    } else {
        const int rloc = wave * 8 + (lane >> 3), irow = half * 32 + rloc, jq = lane & 7, j0 = jq * 8;
        f32x2 s0 = (f32x2){0.f, 0.f}, s1 = s0, s2 = s0, s3 = s0;
        const unsigned lds0 = (unsigned)(size_t)buf;
        __syncthreads();
#define DSR128(dst, addr, off) asm volatile("ds_read_b128 %0, %1 offset:%2" : "=v"(dst) : "v"(addr), "n"(off))
#define DSR32(dst, addr, off) asm volatile("ds_read_b32 %0, %1 offset:%2" : "=v"(dst) : "v"(addr), "n"(off))
#define SC_PART1(PE) const f32x2 pa = (s0 * (f32x2){PE##A0.x, PE##A0.y} + s1 * (f32x2){PE##A0.z, PE##A0.w}) + (s2 * (f32x2){PE##A1.x, PE##A1.y} + s3 * (f32x2){PE##A1.z, PE##A1.w}); \
                const f32x2 v2 = (f32x2){PE##v, PE##v}; \
                const f32x2 t0 = s0 * (f32x2){PE##W0.x, PE##W0.y} + v2 * (f32x2){PE##K0.x, PE##K0.y}, t1 = s1 * (f32x2){PE##W0.z, PE##W0.w} + v2 * (f32x2){PE##K0.z, PE##K0.w}; \
                const f32x2 t2 = s2 * (f32x2){PE##W1.x, PE##W1.y} + v2 * (f32x2){PE##K1.x, PE##K1.y}, t3 = s3 * (f32x2){PE##W1.z, PE##W1.w} + v2 * (f32x2){PE##K1.z, PE##K1.w}; \
                const float sa = red8(pa.x + pa.y); const f32x2 sa2 = (f32x2){sa, sa};
#define SC_PART2(PL, tq_, yk_) s0 = t0 + sa2 * (f32x2){PL##B0.x, PL##B0.y}; s1 = t1 + sa2 * (f32x2){PL##B0.z, PL##B0.w}; s2 = t2 + sa2 * (f32x2){PL##B1.x, PL##B1.y}; s3 = t3 + sa2 * (f32x2){PL##B1.z, PL##B1.w}; \
                { const f32x2 py = (s0 * (f32x2){PL##R0.x, PL##R0.y} + s1 * (f32x2){PL##R0.z, PL##R0.w}) + (s2 * (f32x2){PL##R1.x, PL##R1.y} + s3 * (f32x2){PL##R1.z, PL##R1.w}); \
                  const float y = red8(py.x + py.y); yk_ = (jq == (tq_)) ? y : yk_; }
#pragma unroll 1
        for (int c = 0; c < NCH; ++c) {
            const int cur = c & 1;
            LAS float* yb = ybuf + cur * (CT * 32);
            float yk0 = 0.f, yk1 = 0.f, yk2 = 0.f, yk3 = 0.f;
            const unsigned qa = lds0 + (unsigned)(cur * BUFF + j0) * 4u, va = lds0 + (unsigned)(cur * BUFF + 5 * VF32 + irow) * 4u;
            f32x4 EAA0, EAA1, EAW0, EAW1, EAK0, EAK1, EBA0, EBA1, EBW0, EBW1, EBK0, EBK1, ECA0, ECA1, ECW0, ECW1, ECK0, ECK1, LAB0, LAB1, LAR0, LAR1, LBB0, LBB1, LBR0, LBR1; float EAv, EBv, ECv;
            DSR128(EAA0, qa, 8192); DSR128(EAA1, qa, 8208); DSR128(EAW0, qa, 0); DSR128(EAW1, qa, 16); DSR128(EAK0, qa, 24576); DSR128(EAK1, qa, 24592); DSR32(EAv, va, 0); DSR128(LAB0, qa, 16384); DSR128(LAB1, qa, 16400); DSR128(LAR0, qa, 32768); DSR128(LAR1, qa, 32784); DSR128(EBA0, qa, 8448); DSR128(EBA1, qa, 8464); DSR128(EBW0, qa, 256); DSR128(EBW1, qa, 272); DSR128(EBK0, qa, 24832); DSR128(EBK1, qa, 24848); DSR32(EBv, va, 256);
            { asm volatile("s_waitcnt lgkmcnt(11)" : "+v"(EAA0), "+v"(EAA1), "+v"(EAW0), "+v"(EAW1), "+v"(EAK0), "+v"(EAK1), "+v"(EAv)); DSR128(LBB0, qa, 16640); DSR128(LBB1, qa, 16656); DSR128(LBR0, qa, 33024); DSR128(LBR1, qa, 33040); DSR128(ECA0, qa, 8704); DSR128(ECA1, qa, 8720); DSR128(ECW0, qa, 512); DSR128(ECW1, qa, 528); DSR128(ECK0, qa, 25088); DSR128(ECK1, qa, 25104); DSR32(ECv, va, 512); SC_PART1(EA) asm volatile("s_waitcnt lgkmcnt(15)" : "+v"(LAB0), "+v"(LAB1), "+v"(LAR0), "+v"(LAR1)); SC_PART2(LA, 0, yk0) }
            { asm volatile("s_waitcnt lgkmcnt(11)" : "+v"(EBA0), "+v"(EBA1), "+v"(EBW0), "+v"(EBW1), "+v"(EBK0), "+v"(EBK1), "+v"(EBv)); DSR128(LAB0, qa, 16896); DSR128(LAB1, qa, 16912); DSR128(LAR0, qa, 33280); DSR128(LAR1, qa, 33296); DSR128(EAA0, qa, 8960); DSR128(EAA1, qa, 8976); DSR128(EAW0, qa, 768); DSR128(EAW1, qa, 784); DSR128(EAK0, qa, 25344); DSR128(EAK1, qa, 25360); DSR32(EAv, va, 768); SC_PART1(EB) asm volatile("s_waitcnt lgkmcnt(15)" : "+v"(LBB0), "+v"(LBB1), "+v"(LBR0), "+v"(LBR1)); SC_PART2(LB, 1, yk0) }
            { asm volatile("s_waitcnt lgkmcnt(11)" : "+v"(ECA0), "+v"(ECA1), "+v"(ECW0), "+v"(ECW1), "+v"(ECK0), "+v"(ECK1), "+v"(ECv)); DSR128(LBB0, qa, 17152); DSR128(LBB1, qa, 17168); DSR128(LBR0, qa, 33536); DSR128(LBR1, qa, 33552); DSR128(EBA0, qa, 9216); DSR128(EBA1, qa, 9232); DSR128(EBW0, qa, 1024); DSR128(EBW1, qa, 1040); DSR128(EBK0, qa, 25600); DSR128(EBK1, qa, 25616); DSR32(EBv, va, 1024); SC_PART1(EC) asm volatile("s_waitcnt lgkmcnt(15)" : "+v"(LAB0), "+v"(LAB1), "+v"(LAR0), "+v"(LAR1)); SC_PART2(LA, 2, yk0) }
            { asm volatile("s_waitcnt lgkmcnt(11)" : "+v"(EAA0), "+v"(EAA1), "+v"(EAW0), "+v"(EAW1), "+v"(EAK0), "+v"(EAK1), "+v"(EAv)); DSR128(LAB0, qa, 17408); DSR128(LAB1, qa, 17424); DSR128(LAR0, qa, 33792); DSR128(LAR1, qa, 33808); DSR128(ECA0, qa, 9472); DSR128(ECA1, qa, 9488); DSR128(ECW0, qa, 1280); DSR128(ECW1, qa, 1296); DSR128(ECK0, qa, 25856); DSR128(ECK1, qa, 25872); DSR32(ECv, va, 1280); SC_PART1(EA) asm volatile("s_waitcnt lgkmcnt(15)" : "+v"(LBB0), "+v"(LBB1), "+v"(LBR0), "+v"(LBR1)); SC_PART2(LB, 3, yk0) }
            { asm volatile("s_waitcnt lgkmcnt(11)" : "+v"(EBA0), "+v"(EBA1), "+v"(EBW0), "+v"(EBW1), "+v"(EBK0), "+v"(EBK1), "+v"(EBv)); DSR128(LBB0, qa, 17664); DSR128(LBB1, qa, 17680); DSR128(LBR0, qa, 34048); DSR128(LBR1, qa, 34064); DSR128(EAA0, qa, 9728); DSR128(EAA1, qa, 9744); DSR128(EAW0, qa, 1536); DSR128(EAW1, qa, 1552); DSR128(EAK0, qa, 26112); DSR128(EAK1, qa, 26128); DSR32(EAv, va, 1536); SC_PART1(EB) asm volatile("s_waitcnt lgkmcnt(15)" : "+v"(LAB0), "+v"(LAB1), "+v"(LAR0), "+v"(LAR1)); SC_PART2(LA, 4, yk0) }
            { asm volatile("s_waitcnt lgkmcnt(11)" : "+v"(ECA0), "+v"(ECA1), "+v"(ECW0), "+v"(ECW1), "+v"(ECK0), "+v"(ECK1), "+v"(ECv)); DSR128(LAB0, qa, 17920); DSR128(LAB1, qa, 17936); DSR128(LAR0, qa, 34304); DSR128(LAR1, qa, 34320); DSR128(EBA0, qa, 9984); DSR128(EBA1, qa, 10000); DSR128(EBW0, qa, 1792); DSR128(EBW1, qa, 1808); DSR128(EBK0, qa, 26368); DSR128(EBK1, qa, 26384); DSR32(EBv, va, 1792); SC_PART1(EC) asm volatile("s_waitcnt lgkmcnt(15)" : "+v"(LBB0), "+v"(LBB1), "+v"(LBR0), "+v"(LBR1)); SC_PART2(LB, 5, yk0) }
            { asm volatile("s_waitcnt lgkmcnt(11)" : "+v"(EAA0), "+v"(EAA1), "+v"(EAW0), "+v"(EAW1), "+v"(EAK0), "+v"(EAK1), "+v"(EAv)); DSR128(LBB0, qa, 18176); DSR128(LBB1, qa, 18192); DSR128(LBR0, qa, 34560); DSR128(LBR1, qa, 34576); DSR128(ECA0, qa, 10240); DSR128(ECA1, qa, 10256); DSR128(ECW0, qa, 2048); DSR128(ECW1, qa, 2064); DSR128(ECK0, qa, 26624); DSR128(ECK1, qa, 26640); DSR32(ECv, va, 2048); SC_PART1(EA) asm volatile("s_waitcnt lgkmcnt(15)" : "+v"(LAB0), "+v"(LAB1), "+v"(LAR0), "+v"(LAR1)); SC_PART2(LA, 6, yk0) }
            { asm volatile("s_waitcnt lgkmcnt(11)" : "+v"(EBA0), "+v"(EBA1), "+v"(EBW0), "+v"(EBW1), "+v"(EBK0), "+v"(EBK1), "+v"(EBv)); DSR128(LAB0, qa, 18432); DSR128(LAB1, qa, 18448); DSR128(LAR0, qa, 34816); DSR128(LAR1, qa, 34832); DSR128(EAA0, qa, 10496); DSR128(EAA1, qa, 10512); DSR128(EAW0, qa, 2304); DSR128(EAW1, qa, 2320); DSR128(EAK0, qa, 26880); DSR128(EAK1, qa, 26896); DSR32(EAv, va, 2304); SC_PART1(EB) asm volatile("s_waitcnt lgkmcnt(15)" : "+v"(LBB0), "+v"(LBB1), "+v"(LBR0), "+v"(LBR1)); SC_PART2(LB, 7, yk0) }
            { asm volatile("s_waitcnt lgkmcnt(11)" : "+v"(ECA0), "+v"(ECA1), "+v"(ECW0), "+v"(ECW1), "+v"(ECK0), "+v"(ECK1), "+v"(ECv)); DSR128(LBB0, qa, 18688); DSR128(LBB1, qa, 18704); DSR128(LBR0, qa, 35072); DSR128(LBR1, qa, 35088); DSR128(EBA0, qa, 10752); DSR128(EBA1, qa, 10768); DSR128(EBW0, qa, 2560); DSR128(EBW1, qa, 2576); DSR128(EBK0, qa, 27136); DSR128(EBK1, qa, 27152); DSR32(EBv, va, 2560); SC_PART1(EC) asm volatile("s_waitcnt lgkmcnt(15)" : "+v"(LAB0), "+v"(LAB1), "+v"(LAR0), "+v"(LAR1)); SC_PART2(LA, 0, yk1) }
            { asm volatile("s_waitcnt lgkmcnt(11)" : "+v"(EAA0), "+v"(EAA1), "+v"(EAW0), "+v"(EAW1), "+v"(EAK0), "+v"(EAK1), "+v"(EAv)); DSR128(LAB0, qa, 18944); DSR128(LAB1, qa, 18960); DSR128(LAR0, qa, 35328); DSR128(LAR1, qa, 35344); DSR128(ECA0, qa, 11008); DSR128(ECA1, qa, 11024); DSR128(ECW0, qa, 2816); DSR128(ECW1, qa, 2832); DSR128(ECK0, qa, 27392); DSR128(ECK1, qa, 27408); DSR32(ECv, va, 2816); SC_PART1(EA) asm volatile("s_waitcnt lgkmcnt(15)" : "+v"(LBB0), "+v"(LBB1), "+v"(LBR0), "+v"(LBR1)); SC_PART2(LB, 1, yk1) }
            { asm volatile("s_waitcnt lgkmcnt(11)" : "+v"(EBA0), "+v"(EBA1), "+v"(EBW0), "+v"(EBW1), "+v"(EBK0), "+v"(EBK1), "+v"(EBv)); DSR128(LBB0, qa, 19200); DSR128(LBB1, qa, 19216); DSR128(LBR0, qa, 35584); DSR128(LBR1, qa, 35600); DSR128(EAA0, qa, 11264); DSR128(EAA1, qa, 11280); DSR128(EAW0, qa, 3072); DSR128(EAW1, qa, 3088); DSR128(EAK0, qa, 27648); DSR128(EAK1, qa, 27664); DSR32(EAv, va, 3072); SC_PART1(EB) asm volatile("s_waitcnt lgkmcnt(15)" : "+v"(LAB0), "+v"(LAB1), "+v"(LAR0), "+v"(LAR1)); SC_PART2(LA, 2, yk1) }
            { asm volatile("s_waitcnt lgkmcnt(11)" : "+v"(ECA0), "+v"(ECA1), "+v"(ECW0), "+v"(ECW1), "+v"(ECK0), "+v"(ECK1), "+v"(ECv)); DSR128(LAB0, qa, 19456); DSR128(LAB1, qa, 19472); DSR128(LAR0, qa, 35840); DSR128(LAR1, qa, 35856); DSR128(EBA0, qa, 11520); DSR128(EBA1, qa, 11536); DSR128(EBW0, qa, 3328); DSR128(EBW1, qa, 3344); DSR128(EBK0, qa, 27904); DSR128(EBK1, qa, 27920); DSR32(EBv, va, 3328); SC_PART1(EC) asm volatile("s_waitcnt lgkmcnt(15)" : "+v"(LBB0), "+v"(LBB1), "+v"(LBR0), "+v"(LBR1)); SC_PART2(LB, 3, yk1) }
            { asm volatile("s_waitcnt lgkmcnt(11)" : "+v"(EAA0), "+v"(EAA1), "+v"(EAW0), "+v"(EAW1), "+v"(EAK0), "+v"(EAK1), "+v"(EAv)); DSR128(LBB0, qa, 19712); DSR128(LBB1, qa, 19728); DSR128(LBR0, qa, 36096); DSR128(LBR1, qa, 36112); DSR128(ECA0, qa, 11776); DSR128(ECA1, qa, 11792); DSR128(ECW0, qa, 3584); DSR128(ECW1, qa, 3600); DSR128(ECK0, qa, 28160); DSR128(ECK1, qa, 28176); DSR32(ECv, va, 3584); SC_PART1(EA) asm volatile("s_waitcnt lgkmcnt(15)" : "+v"(LAB0), "+v"(LAB1), "+v"(LAR0), "+v"(LAR1)); SC_PART2(LA, 4, yk1) }
            { asm volatile("s_waitcnt lgkmcnt(11)" : "+v"(EBA0), "+v"(EBA1), "+v"(EBW0), "+v"(EBW1), "+v"(EBK0), "+v"(EBK1), "+v"(EBv)); DSR128(LAB0, qa, 19968); DSR128(LAB1, qa, 19984); DSR128(LAR0, qa, 36352); DSR128(LAR1, qa, 36368); DSR128(EAA0, qa, 12032); DSR128(EAA1, qa, 12048); DSR128(EAW0, qa, 3840); DSR128(EAW1, qa, 3856); DSR128(EAK0, qa, 28416); DSR128(EAK1, qa, 28432); DSR32(EAv, va, 3840); SC_PART1(EB) asm volatile("s_waitcnt lgkmcnt(15)" : "+v"(LBB0), "+v"(LBB1), "+v"(LBR0), "+v"(LBR1)); SC_PART2(LB, 5, yk1) }
            { asm volatile("s_waitcnt lgkmcnt(11)" : "+v"(ECA0), "+v"(ECA1), "+v"(ECW0), "+v"(ECW1), "+v"(ECK0), "+v"(ECK1), "+v"(ECv)); DSR128(LBB0, qa, 20224); DSR128(LBB1, qa, 20240); DSR128(LBR0, qa, 36608); DSR128(LBR1, qa, 36624); DSR128(EBA0, qa, 12288); DSR128(EBA1, qa, 12304); DSR128(EBW0, qa, 4096); DSR128(EBW1, qa, 4112); DSR128(EBK0, qa, 28672); DSR128(EBK1, qa, 28688); DSR32(EBv, va, 4096); SC_PART1(EC) asm volatile("s_waitcnt lgkmcnt(15)" : "+v"(LAB0), "+v"(LAB1), "+v"(LAR0), "+v"(LAR1)); SC_PART2(LA, 6, yk1) }
            { asm volatile("s_waitcnt lgkmcnt(11)" : "+v"(EAA0), "+v"(EAA1), "+v"(EAW0), "+v"(EAW1), "+v"(EAK0), "+v"(EAK1), "+v"(EAv)); DSR128(LAB0, qa, 20480); DSR128(LAB1, qa, 20496); DSR128(LAR0, qa, 36864); DSR128(LAR1, qa, 36880); DSR128(ECA0, qa, 12544); DSR128(ECA1, qa, 12560); DSR128(ECW0, qa, 4352); DSR128(ECW1, qa, 4368); DSR128(ECK0, qa, 28928); DSR128(ECK1, qa, 28944); DSR32(ECv, va, 4352); SC_PART1(EA) asm volatile("s_waitcnt lgkmcnt(15)" : "+v"(LBB0), "+v"(LBB1), "+v"(LBR0), "+v"(LBR1)); SC_PART2(LB, 7, yk1) }
            { asm volatile("s_waitcnt lgkmcnt(11)" : "+v"(EBA0), "+v"(EBA1), "+v"(EBW0), "+v"(EBW1), "+v"(EBK0), "+v"(EBK1), "+v"(EBv)); DSR128(LBB0, qa, 20736); DSR128(LBB1, qa, 20752); DSR128(LBR0, qa, 37120); DSR128(LBR1, qa, 37136); DSR128(EAA0, qa, 12800); DSR128(EAA1, qa, 12816); DSR128(EAW0, qa, 4608); DSR128(EAW1, qa, 4624); DSR128(EAK0, qa, 29184); DSR128(EAK1, qa, 29200); DSR32(EAv, va, 4608); SC_PART1(EB) asm volatile("s_waitcnt lgkmcnt(15)" : "+v"(LAB0), "+v"(LAB1), "+v"(LAR0), "+v"(LAR1)); SC_PART2(LA, 0, yk2) }
            { asm volatile("s_waitcnt lgkmcnt(11)" : "+v"(ECA0), "+v"(ECA1), "+v"(ECW0), "+v"(ECW1), "+v"(ECK0), "+v"(ECK1), "+v"(ECv)); DSR128(LAB0, qa, 20992); DSR128(LAB1, qa, 21008); DSR128(LAR0, qa, 37376); DSR128(LAR1, qa, 37392); DSR128(EBA0, qa, 13056); DSR128(EBA1, qa, 13072); DSR128(EBW0, qa, 4864); DSR128(EBW1, qa, 4880); DSR128(EBK0, qa, 29440); DSR128(EBK1, qa, 29456); DSR32(EBv, va, 4864); SC_PART1(EC) asm volatile("s_waitcnt lgkmcnt(15)" : "+v"(LBB0), "+v"(LBB1), "+v"(LBR0), "+v"(LBR1)); SC_PART2(LB, 1, yk2) }
            { asm volatile("s_waitcnt lgkmcnt(11)" : "+v"(EAA0), "+v"(EAA1), "+v"(EAW0), "+v"(EAW1), "+v"(EAK0), "+v"(EAK1), "+v"(EAv)); DSR128(LBB0, qa, 21248); DSR128(LBB1, qa, 21264); DSR128(LBR0, qa, 37632); DSR128(LBR1, qa, 37648); DSR128(ECA0, qa, 13312); DSR128(ECA1, qa, 13328); DSR128(ECW0, qa, 5120); DSR128(ECW1, qa, 5136); DSR128(ECK0, qa, 29696); DSR128(ECK1, qa, 29712); DSR32(ECv, va, 5120); SC_PART1(EA) asm volatile("s_waitcnt lgkmcnt(15)" : "+v"(LAB0), "+v"(LAB1), "+v"(LAR0), "+v"(LAR1)); SC_PART2(LA, 2, yk2) }
            { asm volatile("s_waitcnt lgkmcnt(11)" : "+v"(EBA0), "+v"(EBA1), "+v"(EBW0), "+v"(EBW1), "+v"(EBK0), "+v"(EBK1), "+v"(EBv)); DSR128(LAB0, qa, 21504); DSR128(LAB1, qa, 21520); DSR128(LAR0, qa, 37888); DSR128(LAR1, qa, 37904); DSR128(EAA0, qa, 13568); DSR128(EAA1, qa, 13584); DSR128(EAW0, qa, 5376); DSR128(EAW1, qa, 5392); DSR128(EAK0, qa, 29952); DSR128(EAK1, qa, 29968); DSR32(EAv, va, 5376); SC_PART1(EB) asm volatile("s_waitcnt lgkmcnt(15)" : "+v"(LBB0), "+v"(LBB1), "+v"(LBR0), "+v"(LBR1)); SC_PART2(LB, 3, yk2) }
            { asm volatile("s_waitcnt lgkmcnt(11)" : "+v"(ECA0), "+v"(ECA1), "+v"(ECW0), "+v"(ECW1), "+v"(ECK0), "+v"(ECK1), "+v"(ECv)); DSR128(LBB0, qa, 21760); DSR128(LBB1, qa, 21776); DSR128(LBR0, qa, 38144); DSR128(LBR1, qa, 38160); DSR128(EBA0, qa, 13824); DSR128(EBA1, qa, 13840); DSR128(EBW0, qa, 5632); DSR128(EBW1, qa, 5648); DSR128(EBK0, qa, 30208); DSR128(EBK1, qa, 30224); DSR32(EBv, va, 5632); SC_PART1(EC) asm volatile("s_waitcnt lgkmcnt(15)" : "+v"(LAB0), "+v"(LAB1), "+v"(LAR0), "+v"(LAR1)); SC_PART2(LA, 4, yk2) }
            { asm volatile("s_waitcnt lgkmcnt(11)" : "+v"(EAA0), "+v"(EAA1), "+v"(EAW0), "+v"(EAW1), "+v"(EAK0), "+v"(EAK1), "+v"(EAv)); DSR128(LAB0, qa, 22016); DSR128(LAB1, qa, 22032); DSR128(LAR0, qa, 38400); DSR128(LAR1, qa, 38416); DSR128(ECA0, qa, 14080); DSR128(ECA1, qa, 14096); DSR128(ECW0, qa, 5888); DSR128(ECW1, qa, 5904); DSR128(ECK0, qa, 30464); DSR128(ECK1, qa, 30480); DSR32(ECv, va, 5888); SC_PART1(EA) asm volatile("s_waitcnt lgkmcnt(15)" : "+v"(LBB0), "+v"(LBB1), "+v"(LBR0), "+v"(LBR1)); SC_PART2(LB, 5, yk2) }
            { asm volatile("s_waitcnt lgkmcnt(11)" : "+v"(EBA0), "+v"(EBA1), "+v"(EBW0), "+v"(EBW1), "+v"(EBK0), "+v"(EBK1), "+v"(EBv)); DSR128(LBB0, qa, 22272); DSR128(LBB1, qa, 22288); DSR128(LBR0, qa, 38656); DSR128(LBR1, qa, 38672); DSR128(EAA0, qa, 14336); DSR128(EAA1, qa, 14352); DSR128(EAW0, qa, 6144); DSR128(EAW1, qa, 6160); DSR128(EAK0, qa, 30720); DSR128(EAK1, qa, 30736); DSR32(EAv, va, 6144); SC_PART1(EB) asm volatile("s_waitcnt lgkmcnt(15)" : "+v"(LAB0), "+v"(LAB1), "+v"(LAR0), "+v"(LAR1)); SC_PART2(LA, 6, yk2) }
            { asm volatile("s_waitcnt lgkmcnt(11)" : "+v"(ECA0), "+v"(ECA1), "+v"(ECW0), "+v"(ECW1), "+v"(ECK0), "+v"(ECK1), "+v"(ECv)); DSR128(LAB0, qa, 22528); DSR128(LAB1, qa, 22544); DSR128(LAR0, qa, 38912); DSR128(LAR1, qa, 38928); DSR128(EBA0, qa, 14592); DSR128(EBA1, qa, 14608); DSR128(EBW0, qa, 6400); DSR128(EBW1, qa, 6416); DSR128(EBK0, qa, 30976); DSR128(EBK1, qa, 30992); DSR32(EBv, va, 6400); SC_PART1(EC) asm volatile("s_waitcnt lgkmcnt(15)" : "+v"(LBB0), "+v"(LBB1), "+v"(LBR0), "+v"(LBR1)); SC_PART2(LB, 7, yk2) }
            { asm volatile("s_waitcnt lgkmcnt(11)" : "+v"(EAA0), "+v"(EAA1), "+v"(EAW0), "+v"(EAW1), "+v"(EAK0), "+v"(EAK1), "+v"(EAv)); DSR128(LBB0, qa, 22784); DSR128(LBB1, qa, 22800); DSR128(LBR0, qa, 39168); DSR128(LBR1, qa, 39184); DSR128(ECA0, qa, 14848); DSR128(ECA1, qa, 14864); DSR128(ECW0, qa, 6656); DSR128(ECW1, qa, 6672); DSR128(ECK0, qa, 31232); DSR128(ECK1, qa, 31248); DSR32(ECv, va, 6656); SC_PART1(EA) asm volatile("s_waitcnt lgkmcnt(15)" : "+v"(LAB0), "+v"(LAB1), "+v"(LAR0), "+v"(LAR1)); SC_PART2(LA, 0, yk3) }
            { asm volatile("s_waitcnt lgkmcnt(11)" : "+v"(EBA0), "+v"(EBA1), "+v"(EBW0), "+v"(EBW1), "+v"(EBK0), "+v"(EBK1), "+v"(EBv)); DSR128(LAB0, qa, 23040); DSR128(LAB1, qa, 23056); DSR128(LAR0, qa, 39424); DSR128(LAR1, qa, 39440); DSR128(EAA0, qa, 15104); DSR128(EAA1, qa, 15120); DSR128(EAW0, qa, 6912); DSR128(EAW1, qa, 6928); DSR128(EAK0, qa, 31488); DSR128(EAK1, qa, 31504); DSR32(EAv, va, 6912); SC_PART1(EB) asm volatile("s_waitcnt lgkmcnt(15)" : "+v"(LBB0), "+v"(LBB1), "+v"(LBR0), "+v"(LBR1)); SC_PART2(LB, 1, yk3) }
            { asm volatile("s_waitcnt lgkmcnt(11)" : "+v"(ECA0), "+v"(ECA1), "+v"(ECW0), "+v"(ECW1), "+v"(ECK0), "+v"(ECK1), "+v"(ECv)); DSR128(LBB0, qa, 23296); DSR128(LBB1, qa, 23312); DSR128(LBR0, qa, 39680); DSR128(LBR1, qa, 39696); DSR128(EBA0, qa, 15360); DSR128(EBA1, qa, 15376); DSR128(EBW0, qa, 7168); DSR128(EBW1, qa, 7184); DSR128(EBK0, qa, 31744); DSR128(EBK1, qa, 31760); DSR32(EBv, va, 7168); SC_PART1(EC) asm volatile("s_waitcnt lgkmcnt(15)" : "+v"(LAB0), "+v"(LAB1), "+v"(LAR0), "+v"(LAR1)); SC_PART2(LA, 2, yk3) }
            { asm volatile("s_waitcnt lgkmcnt(11)" : "+v"(EAA0), "+v"(EAA1), "+v"(EAW0), "+v"(EAW1), "+v"(EAK0), "+v"(EAK1), "+v"(EAv)); DSR128(LAB0, qa, 23552); DSR128(LAB1, qa, 23568); DSR128(LAR0, qa, 39936); DSR128(LAR1, qa, 39952); DSR128(ECA0, qa, 15616); DSR128(ECA1, qa, 15632); DSR128(ECW0, qa, 7424); DSR128(ECW1, qa, 7440); DSR128(ECK0, qa, 32000); DSR128(ECK1, qa, 32016); DSR32(ECv, va, 7424); SC_PART1(EA) asm volatile("s_waitcnt lgkmcnt(15)" : "+v"(LBB0), "+v"(LBB1), "+v"(LBR0), "+v"(LBR1)); SC_PART2(LB, 3, yk3) }
            { asm volatile("s_waitcnt lgkmcnt(11)" : "+v"(EBA0), "+v"(EBA1), "+v"(EBW0), "+v"(EBW1), "+v"(EBK0), "+v"(EBK1), "+v"(EBv)); DSR128(LBB0, qa, 23808); DSR128(LBB1, qa, 23824); DSR128(LBR0, qa, 40192); DSR128(LBR1, qa, 40208); DSR128(EAA0, qa, 15872); DSR128(EAA1, qa, 15888); DSR128(EAW0, qa, 7680); DSR128(EAW1, qa, 7696); DSR128(EAK0, qa, 32256); DSR128(EAK1, qa, 32272); DSR32(EAv, va, 7680); SC_PART1(EB) asm volatile("s_waitcnt lgkmcnt(15)" : "+v"(LAB0), "+v"(LAB1), "+v"(LAR0), "+v"(LAR1)); SC_PART2(LA, 4, yk3) }
            { asm volatile("s_waitcnt lgkmcnt(11)" : "+v"(ECA0), "+v"(ECA1), "+v"(ECW0), "+v"(ECW1), "+v"(ECK0), "+v"(ECK1), "+v"(ECv)); DSR128(LAB0, qa, 24064); DSR128(LAB1, qa, 24080); DSR128(LAR0, qa, 40448); DSR128(LAR1, qa, 40464); DSR128(EBA0, qa, 16128); DSR128(EBA1, qa, 16144); DSR128(EBW0, qa, 7936); DSR128(EBW1, qa, 7952); DSR128(EBK0, qa, 32512); DSR128(EBK1, qa, 32528); DSR32(EBv, va, 7936); SC_PART1(EC) asm volatile("s_waitcnt lgkmcnt(15)" : "+v"(LBB0), "+v"(LBB1), "+v"(LBR0), "+v"(LBR1)); SC_PART2(LB, 5, yk3) }
            { asm volatile("s_waitcnt lgkmcnt(11)" : "+v"(EAA0), "+v"(EAA1), "+v"(EAW0), "+v"(EAW1), "+v"(EAK0), "+v"(EAK1), "+v"(EAv)); DSR128(LBB0, qa, 24320); DSR128(LBB1, qa, 24336); DSR128(LBR0, qa, 40704); DSR128(LBR1, qa, 40720); SC_PART1(EA) asm volatile("s_waitcnt lgkmcnt(11)" : "+v"(LAB0), "+v"(LAB1), "+v"(LAR0), "+v"(LAR1)); SC_PART2(LA, 6, yk3) }
            { asm volatile("s_waitcnt lgkmcnt(4)" : "+v"(EBA0), "+v"(EBA1), "+v"(EBW0), "+v"(EBW1), "+v"(EBK0), "+v"(EBK1), "+v"(EBv)); SC_PART1(EB) asm volatile("s_waitcnt lgkmcnt(0)" : "+v"(LBB0), "+v"(LBB1), "+v"(LBR0), "+v"(LBR1)); SC_PART2(LB, 7, yk3) }
            yb[jq * 32 + rloc] = yk0; yb[(jq + 8) * 32 + rloc] = yk1; yb[(jq + 16) * 32 + rloc] = yk2; yb[(jq + 24) * 32 + rloc] = yk3;
            __syncthreads();
        }
#undef DSR128
#undef DSR32
#undef SC_PART1
#undef SC_PART2
    }
}
__device__ __forceinline__ void post_phase(bf16_t* Y, bf16_t* Yo, const bf16_t* __restrict__ V, int ldv, const bf16_t* __restrict__ GT, const float* __restrict__ CB, const float* gn_w, const float* gn_b, int ghw, int NHW, int tid) {
    const int jp = tid & 31, h = ghw & 7, col = h * 64 + 2 * jp;
    const float gw0 = gn_w[col], gw1 = gn_w[col + 1], gb0 = gn_b[col], gb1 = gn_b[col + 1];
    for (int g0 = ghw; g0 < M * 8; g0 += 8 * NHW) {
        unsigned yw[8], vw[8], gg[8]; float bon[8];
#pragma unroll
        for (int u = 0; u < 8; ++u) { const int g = g0 + u * NHW; const size_t m = (size_t)(g >> 3);
            yw[u] = *(const unsigned*)(Y + m * 512 + col); vw[u] = *(const unsigned*)(V + m * (size_t)ldv + col); gg[u] = *(const unsigned*)(GT + m * 512 + col); bon[u] = CB[g]; }
#pragma unroll
        for (int u = 0; u < 8; ++u) { const int g = g0 + u * NHW; const size_t m = (size_t)(g >> 3);
            const float y0 = bflo(yw[u]), y1 = bfhi(yw[u]);
            const float mean = half_sum(y0 + y1) * (1.f / 64.f);
            const float d0 = y0 - mean, d1 = y1 - mean;
            const float var = half_sum(d0 * d0 + d1 * d1) * (1.f / 64.f);
            const float rs = rsqrtf(var + 64e-5f);
            const float o0 = (d0 * rs * gw0 + gb0 + bon[u] * bflo(vw[u])) * bflo(gg[u]), o1 = (d1 * rs * gw1 + gb1 + bon[u] * bfhi(vw[u])) * bfhi(gg[u]);
            *(unsigned*)(Yo + m * 1024 + col) = pk2(o0, o1); }
    }
}

#define XB_TMO      128
#define XB_XCNT(j)  (256  + 64 * (j))
#define XB_XSUB(j)  (1280 + 64 * (j))
#define XB_XGEN(j)  (2304 + 64 * (j))
#define XB_TOP      3328
#define XB_TOPGEN   3392
#define XCD_BAR_WORDS 3456
#define XB_SPIN_CAP (1u << 18)

__device__ __forceinline__ unsigned xb_ld(unsigned* p)              { return __hip_atomic_load(p, __ATOMIC_RELAXED, __HIP_MEMORY_SCOPE_AGENT); }
__device__ __forceinline__ unsigned xb_add(unsigned* p, unsigned v) { return __hip_atomic_fetch_add(p, v, __ATOMIC_RELAXED, __HIP_MEMORY_SCOPE_AGENT); }
__device__ __forceinline__ unsigned xb_xcc_id() { return (unsigned)__builtin_amdgcn_s_getreg((3 << 11) | 20) & 0xFu; }
#define XB_SPIN(cond, bar) do { unsigned _sp = 0; while (cond) { __builtin_amdgcn_s_sleep(1); \
    if ((++_sp & 255u) == 0u) { if (xb_ld(&(bar)[XB_TMO])) break; if (_sp > XB_SPIN_CAP) { atomicAdd(&(bar)[XB_TMO], 1u); break; } } } } while (0)

struct XcdBarrier {
    unsigned* bar; unsigned x;
    volatile LAS unsigned* st;
};

__device__ __forceinline__ XcdBarrier xcd_barrier_post(unsigned* bar, volatile LAS unsigned* st) {
    XcdBarrier b; b.bar = bar; b.x = xb_xcc_id(); b.st = st;
    if (threadIdx.x == 0) (void)xb_add(&bar[XB_XCNT(b.x)], 1u);
    return b;
}
__device__ __forceinline__ void xcd_barrier_complete(unsigned* bar, unsigned x, unsigned& nloc, unsigned& nx) {
    const unsigned G = gridDim.x * gridDim.y * gridDim.z;
    unsigned sum, cnt, mine, sp = 0u;
    for (;;) {
        sum = 0u; cnt = 0u; mine = 0u;
#pragma unroll
        for (unsigned j = 0; j < 16; ++j) { const unsigned c = xb_ld(&bar[XB_XCNT(j)]); sum += c; cnt += (c > 0u) ? 1u : 0u; mine = (j == x) ? c : mine; }
        if (sum == G) break;
        __builtin_amdgcn_s_sleep(1);
        if ((++sp & 255u) == 0u) { if (xb_ld(&bar[XB_TMO])) break; if (sp > XB_SPIN_CAP) { atomicAdd(&bar[XB_TMO], 1u); break; } }
    }
    nloc = mine > 0u ? mine : 1u; nx = cnt > 0u ? cnt : 1u;
}

__device__ __forceinline__ void xcd_barrier(const XcdBarrier& b) {
    asm volatile("s_waitcnt vmcnt(0)" ::: "memory");
    __syncthreads();
    if (threadIdx.x == 0) {
        unsigned* bar = b.bar;
        __builtin_amdgcn_s_waitcnt(0);
        unsigned nloc = b.st[0], nx = b.st[1];
        if (nloc == 0u) { xcd_barrier_complete(bar, b.x, nloc, nx); b.st[0] = nloc; b.st[1] = nx; }
        const unsigned old = xb_add(&bar[XB_XSUB(b.x)], 1u);
        const unsigned gen = old / nloc;
        if (old + 1u == (gen + 1u) * nloc) {
            __builtin_amdgcn_fence(__ATOMIC_RELEASE, "agent");
            asm volatile("s_waitcnt vmcnt(0)" ::: "memory");
            const unsigned og = xb_add(&bar[XB_TOP], 1u);
            const unsigned tg = og / nx;
            if (og + 1u == (tg + 1u) * nx) xb_add(&bar[XB_TOPGEN], 1u);
            else XB_SPIN(xb_ld(&bar[XB_TOPGEN]) == tg, bar);
            __builtin_amdgcn_fence(__ATOMIC_ACQUIRE, "agent");
            xb_add(&bar[XB_XGEN(b.x)], 1u);
            asm volatile("s_waitcnt vmcnt(0)" ::: "memory");
        } else {
            XB_SPIN(xb_ld(&bar[XB_XGEN(b.x)]) == gen, bar);
            __builtin_amdgcn_fence(__ATOMIC_ACQUIRE, "agent");
            asm volatile("s_waitcnt vmcnt(0)" ::: "memory");
        }
    }
    __syncthreads();
}


#ifndef PHM
#define PHM 0xFFFF
#endif
#define PH(k) ((PHM >> (k)) & 1)
#ifndef DUPM
#define DUPM 0
#endif
#define DUP(k) ((DUPM >> (k)) & 1)
#define REP(k) for (int rep_ = 0; rep_ < PH(k) + DUP(k); ++rep_)
#define WSP(T, off) ((T*)(T GAS*)(q->ws + (off)))
__global__ void __launch_bounds__(512, 2) mega_fwd(Params p_unused) {
    extern __shared__ __attribute__((aligned(16))) unsigned char lds_raw[];
    LAS unsigned char* lds = (LAS unsigned char*)lds_raw;
    cg::grid_group grid = cg::this_grid();
    const int G = gridDim.x, NGW = G * 8, NT = G * 512;
    volatile LAS unsigned* bst = (volatile LAS unsigned*)(lds + 131072);
    if (threadIdx.x < 2) bst[threadIdx.x] = 0u;
    __syncthreads();
    const XcdBarrier xbar = xcd_barrier_post((unsigned*)(((const Params*)__builtin_amdgcn_kernarg_segment_ptr())->ws + WS_BAR), bst);
#define GSYNC() xcd_barrier(xbar)

    REP(0) { const Params* q = opaque_params(); const int t_ = opaque_tid(); prologue(*q, lds, t_, t_ & 63, __builtin_amdgcn_readfirstlane(t_ >> 6), opaque_bid(), G); }
    grid.sync();

#pragma unroll 1
    for (int l = 0; l < NL; ++l) {
        REP(1) { const Params* q = opaque_params(); const int t_ = opaque_tid();
            norm_phase(l == 0 ? GP(q->x) : ((float*)(q->out)), GP(q->norm1_g) + l * DM, WSP(const float, WS_MOD) + (size_t)l * NB * NMOD, 0, WSP(bf16_t, WS_H), opaque_bid() * 8 + (t_ >> 6), NGW, t_ & 63); }
        GSYNC();
        REP(2) { const Params* q = opaque_params(); const bf16_t* Wl = WSP(const bf16_t, 0) + (size_t)l * LW;
            pg8::Gemm g{WSP(bf16_t, WS_H), Wl + O_IN, DM, DM, M, INC, DM}; pg8::StaticOrder S; S.init(M, INC, G, opaque_bid());
            pg8::EpiInproj E{WSP(bf16_t, WS_PRW), WSP(bf16_t, WS_PGM), WSP(bf16_t, WS_G)};
            pg8::gemm_phase<pg8::EpiInproj, true>(lds, g, S, E); }
        GSYNC();
        if (PH(3)) { const Params* q = opaque_params(); const int t_ = opaque_tid(); const bf16_t* Wl = WSP(const bf16_t, 0) + (size_t)l * LW;
            for (int it = opaque_bid(); it < M / 128; it += G)
                gmlp_item(lds, WSP(bf16_t, WS_PGM), WSP(bf16_t, WS_PGM), Wl + O_WS, GP(q->ln_w) + l * 512, GP(q->ln_b) + l * 512, GP(q->b_sp) + l * 512, it, t_, t_ & 63, __builtin_amdgcn_readfirstlane(t_ >> 6)); }
        REP(4) { const Params* q = opaque_params();
            prep1_phase(WSP(bf16_t, WS_PRW), GP(q->mu_shift) + l * RWC, WSP(bf16_t, WS_R), WSP(bf16_t, WS_K0), l == 0 ? WSP(bf16_t, WS_VF) : WSP(bf16_t, WS_V0), WSP(bf16_t, WS_LIN), opaque_bid() * 512 + opaque_tid(), NT); }
        GSYNC();
        REP(5) { const Params* q = opaque_params(); const bf16_t* Wl = WSP(const bf16_t, 0) + (size_t)l * LW;
            pg8::Gemm g{WSP(bf16_t, WS_LIN), Wl + O_LORA, 256, 256, M, 1536, 128, 4, 128};    pg8::StaticOrder S; S.init(M, 1536, G, opaque_bid());
            pg8::EpiLora E{WSP(bf16_t, WS_OMD)};
            pg8::gemm_phase<pg8::EpiLora, true>(lds, g, S, E); }
        if (l > 0) REP(6) { const Params* q = opaque_params(); const bf16_t* Wl = WSP(const bf16_t, 0) + (size_t)l * LW;
            pg8::Gemm g{WSP(bf16_t, WS_V0), Wl + O_V12, 512, 512, M, 512, 512}; pg8::StaticOrder S; S.init(M, 512, G, opaque_bid());
            pg8::EpiVres E{WSP(bf16_t, WS_V0), WSP(bf16_t, WS_VF), WSP(bf16_t, WS_PGM) + 512, 1024, GP(q->v0_res) + (l - 1) * 512};
            pg8::gemm_phase<pg8::EpiVres, true>(lds, g, S, E); }
        GSYNC();
        REP(7) { const Params* q = opaque_params();
            scan_phase(lds, WSP(bf16_t, WS_R), WSP(bf16_t, WS_K0), WSP(bf16_t, WS_ASIG), WSP(bf16_t, WS_OMD), l == 0 ? WSP(bf16_t, WS_VF) : WSP(bf16_t, WS_PGM) + 512, l == 0 ? 512 : 1024,
                       WSP(bf16_t, WS_YRW), WSP(float, WS_CB), GP(q->k_k) + l * 512, GP(q->k_a) + l * 512, GP(q->r_k) + l * 512, GP(q->w0_decay) + l * 512, GP(q->a0) + l * 512, opaque_bid(), opaque_tid()); }
        GSYNC();
        REP(13) { const Params* q = opaque_params(); const int t_ = opaque_tid();
            post_phase(WSP(bf16_t, WS_YRW), WSP(bf16_t, WS_PGM) + 512, l == 0 ? WSP(bf16_t, WS_VF) : WSP(bf16_t, WS_PGM) + 512, l == 0 ? 512 : 1024, WSP(bf16_t, WS_GT), WSP(const float, WS_CB),
                       GP(q->gn_w) + l * 512, GP(q->gn_b) + l * 512, opaque_bid() * 16 + (t_ >> 5), G * 16, t_); }
        GSYNC();
        REP(8) { const Params* q = opaque_params(); const bf16_t* Wl = WSP(const bf16_t, 0) + (size_t)l * LW;
            pg8::StaticOrder S; S.init(M, DM, G, opaque_bid());
            pg8::Gemm g1{WSP(bf16_t, WS_PGM), Wl + O_BR1, 1024, 1024, M, DM, 1024}; pg8::EpiMergeF E1{WSP(bf16_t, WS_G), WSP(bf16_t, WS_MG)};
            pg8::gemm_phase<pg8::EpiMergeF, true, true>(lds, g1, S, E1); }
        GSYNC();
        REP(9) { const Params* q = opaque_params(); const bf16_t* Wl = WSP(const bf16_t, 0) + (size_t)l * LW;
            pg8::Gemm g{WSP(bf16_t, WS_MG), Wl + O_OUT, DM, DM, M, DM, DM}; pg8::StaticOrder S; S.init(M, DM, G, opaque_bid());
            pg8::EpiResid E{l == 0 ? GP(q->x) : ((float*)(q->out)), ((float*)(q->out)), WSP(const float, WS_MOD) + (size_t)l * NB * NMOD + 2 * DM};
            pg8::gemm_phase<pg8::EpiResid, true>(lds, g, S, E); }
        GSYNC();
        REP(10) { const Params* q = opaque_params(); const int t_ = opaque_tid();
            norm_phase(((float*)(q->out)), GP(q->norm2_g) + l * DM, WSP(const float, WS_MOD) + (size_t)l * NB * NMOD, 3 * DM, WSP(bf16_t, WS_H), opaque_bid() * 8 + (t_ >> 6), NGW, t_ & 63); }
        GSYNC();
        REP(11) { const Params* q = opaque_params(); const bf16_t* Wl = WSP(const bf16_t, 0) + (size_t)l * LW;
            pg8::Gemm g{WSP(bf16_t, WS_H), Wl + O_FF1, DM, DM, M, DFF, DM}; pg8::StaticOrder S; S.init(M, DFF, G, opaque_bid());
            pg8::EpiFF1 E{WSP(bf16_t, WS_FH)};
            pg8::gemm_phase<pg8::EpiFF1, true>(lds, g, S, E); }
        GSYNC();
        REP(12) { const Params* q = opaque_params(); const bf16_t* Wl = WSP(const bf16_t, 0) + (size_t)l * LW;
            pg8::Gemm g{WSP(bf16_t, WS_FH), Wl + O_FF2, DFF, DFF, M, DM, DFF}; pg8::StaticOrder S; S.init(M, DM, G, opaque_bid());
            pg8::EpiResid E{((float*)(q->out)), ((float*)(q->out)), WSP(const float, WS_MOD) + (size_t)l * NB * NMOD + 5 * DM};
            pg8::gemm_phase<pg8::EpiResid, true>(lds, g, S, E); }
        GSYNC();
    }
    { const Params* q = opaque_params(); const int t_ = opaque_tid(); final_norm(((float*)(q->out)), GP(q->final_g), opaque_bid() * 8 + (t_ >> 6), NGW, t_ & 63); }
}

extern "C" void kernel_launch(void* const* d_in, const int* in_sizes, int n_in, void* d_out, int out_size, void* d_ws, size_t ws_size, hipStream_t stream) {
    static int grid = 0;
    if (grid == 0) {
        if (n_in != 31 || ws_size < WS_END) { fprintf(stderr, "kernel_launch: unexpected n_in %d / ws_size %zu\n", n_in, ws_size); grid = -1; return; }
        int dev = 0, cus = 0, per_cu = 0;
        hipGetDevice(&dev);
        hipDeviceGetAttribute(&cus, hipDeviceAttributeMultiprocessorCount, dev);
        hipFuncSetAttribute((const void*)mega_fwd, hipFuncAttributeMaxDynamicSharedMemorySize, LDS_BYTES);
        hipOccupancyMaxActiveBlocksPerMultiprocessor(&per_cu, (const void*)mega_fwd, 512, LDS_BYTES);
        if (per_cu < 1) { fprintf(stderr, "kernel_launch: occupancy query says %d blocks/CU\n", per_cu); per_cu = 1; }
        if (cus != 256) { fprintf(stderr, "kernel_launch: built for 256 CUs, found %d\n", cus); grid = -1; return; }
        grid = cus;
        (void)hipGetLastError();
    }
    if (grid < 0) return;
    Params p{};
    const float** pp = (const float**)&p;
    for (int i = 0; i < 31; ++i) pp[i] = (const float*)d_in[i];
    p.out = (float GAS*)d_out; p.ws = (unsigned char GAS*)d_ws;
    if (hipMemsetAsync((char*)d_ws + WS_BAR, 0, WS_BAR_BYTES, stream) != hipSuccess) { fprintf(stderr, "kernel_launch: memset of the barrier words failed\n"); return; }
    void* args[] = {&p};
    hipError_t e = hipLaunchCooperativeKernel((const void*)mega_fwd, dim3(grid), dim3(512), args, LDS_BYTES, stream);
    if (e != hipSuccess) fprintf(stderr, "cooperative launch failed: %s (grid %d)\n", hipGetErrorString(e), grid);
}
```

```cpp
#include <hip/hip_runtime.h>
#include <hip/hip_cooperative_groups.h>
#include <cstdio>
#include <cstdint>
namespace cg = cooperative_groups;

#define LAS __attribute__((address_space(3)))
typedef unsigned short bf16_t;
typedef short bf16x8 __attribute__((ext_vector_type(8)));
typedef float f32x4 __attribute__((ext_vector_type(4)));
typedef float f32x2 __attribute__((ext_vector_type(2)));
typedef unsigned u32x4 __attribute__((ext_vector_type(4)));
typedef unsigned u32x2 __attribute__((ext_vector_type(2)));

constexpr int NB = 16, SEQ = 4096, DM = 1024, M = NB * SEQ, NL = 4;
constexpr int RW = 512, INC = 4864, RWC = 1792, DFF = 4096, NMOD = 6 * DM;
constexpr size_t U = 64ull << 20;
constexpr size_t O_IN = 0, O_LORA = O_IN + 4864ull * 1024, O_V12 = O_LORA + 1536ull * 256, O_WS = O_V12 + 512ull * 512,
                 O_BR1 = O_WS + 4ull * 128 * 128, O_BR2 = O_BR1 + 1024ull * 512, O_OUT = O_BR2 + 1024ull * 512,
                 O_FF1 = O_OUT + 1024ull * 1024, O_FF2 = O_FF1 + 4096ull * 1024, LW = O_FF2 + 1024ull * 4096;
constexpr size_t WS_BAR = (125ull << 20) + (512ull << 10), WS_BAR_BYTES = 16384;
constexpr size_t WS_MOD = 124ull << 20, WS_CB = 126ull << 20;
static_assert(LW * 2 * NL <= WS_MOD, "weights fit");
constexpr size_t WS_VF = 2 * U, WS_G = 3 * U, WS_PGM = 7 * U, WS_PRW = 9 * U, WS_LIN = 12 * U + U / 2, WS_R = 13 * U, WS_K0 = 14 * U,
                 WS_V0 = 15 * U, WS_YRW = 15 * U, WS_OMD = 9 * U, WS_ASIG = 10 * U, WS_GT = 11 * U, WS_MGF = 9 * U, WS_MG = 13 * U,
                 WS_H = 13 * U, WS_FH = 3 * U, WS_END = 16 * U;
static_assert(WS_ASIG == WS_OMD + U && WS_GT == WS_OMD + 2 * U, "EpiLora output spacing");
constexpr int LDS_BYTES = 135168;

#define GAS __attribute__((address_space(1)))
typedef const float GAS* gcf_t;
struct Params {
    gcf_t x, c, w_ada, b_ada, norm1_g, norm2_g, w_in, mu_shift, w0_decay, w2_decay, a0, w2_aaa, w2_gate, k_k, k_a, r_k,
        gn_w, gn_b, v0_res, w1_res, w2_res, ln_w, ln_b, w_sp, b_sp, w_br_rw, w_br_gm, w_out, w_ff1, w_ff2, final_g;
    float GAS* out; unsigned char GAS* ws;
};

#define GP(ptr_) ((const float*)(ptr_))
__device__ __forceinline__ float bflo(unsigned w) { return __builtin_bit_cast(float, w << 16); }
__device__ __forceinline__ float bfhi(unsigned w) { return __builtin_bit_cast(float, w & 0xffff0000u); }
__device__ __forceinline__ float bf1(bf16_t v) { return __builtin_bit_cast(float, (unsigned)v << 16); }
__device__ __forceinline__ unsigned f2bf(float f) { unsigned u = __builtin_bit_cast(unsigned, f); return (u + 0x7fffu + ((u >> 16) & 1u)) >> 16; }
typedef __bf16 bf16x2_t __attribute__((ext_vector_type(2)));
__device__ __forceinline__ unsigned pk2(float lo, float hi) { const f32x2 v = {lo, hi}; const bf16x2_t b = __builtin_convertvector(v, bf16x2_t); return __builtin_bit_cast(unsigned, b); }
__device__ __forceinline__ float rcpf_(float x) { return __builtin_amdgcn_rcpf(x); }
__device__ __forceinline__ float sigmoidf_(float x) { return rcpf_(1.f + __expf(-x)); }
__device__ __forceinline__ float tanhf_(float x) { return 1.f - 2.f * rcpf_(__expf(2.f * x) + 1.f); }
#define DPP_ADD(x, ctrl) ((x) + __builtin_bit_cast(float, __builtin_amdgcn_update_dpp(0, __builtin_bit_cast(int, (x)), (ctrl), 0xF, 0xF, true)))
__device__ __forceinline__ float red8(float x) { x = DPP_ADD(x, 0xB1); x = DPP_ADD(x, 0x4E); x = DPP_ADD(x, 0x141); return x; }
__device__ __forceinline__ float row_sum16(float x) { x = red8(x); x = DPP_ADD(x, 0x140); return x; }
__device__ __forceinline__ float half_sum(float v) {
    v = row_sum16(v);
    return v + __builtin_bit_cast(float, __builtin_amdgcn_ds_swizzle(__builtin_bit_cast(int, v), 0x401F));
}
__device__ __forceinline__ float wave_sum(float v) {
    v = half_sum(v);
    return __builtin_bit_cast(float, __builtin_amdgcn_readlane(__builtin_bit_cast(int, v), 0)) + __builtin_bit_cast(float, __builtin_amdgcn_readlane(__builtin_bit_cast(int, v), 32));
}
__device__ __forceinline__ int opaque_tid() { int t = threadIdx.x; asm volatile("" : "+v"(t)); return t; }
__device__ __forceinline__ const struct Params* opaque_params() { const struct Params* q = (const struct Params*)__builtin_amdgcn_kernarg_segment_ptr(); asm volatile("" : "+s"(q)); return q; }
__device__ __forceinline__ int opaque_bid() { int b = blockIdx.x; asm volatile("" : "+s"(b)); return b; }
__device__ __forceinline__ float omd_of(float d) {
    const float x = -d, sp = fmaxf(x, 0.f) + 0.69314718f * __builtin_amdgcn_logf(1.f + __builtin_amdgcn_exp2f(-1.44269504f * fabsf(x)));
    const float e = __builtin_amdgcn_exp2f((-sp - 0.5f) * 1.44269504f);
    const float poly = e * (1.f - e * (0.5f - e * (0.16666667f - e * (0.041666668f - e * 0.0083333333f))));
    const float big = 1.f - __builtin_amdgcn_exp2f(-1.44269504f * e);
    return e < 0.125f ? poly : big;
}
__device__ __forceinline__ float decay_of(float d) {
    const float sg = rcpf_(1.f + __builtin_amdgcn_exp2f(-1.44269504f * d));
    return __builtin_amdgcn_exp2f(-0.87503877f * sg);
}
__device__ __forceinline__ float gelu1(float v) {
    const float av = fabsf(v), t = rcpf_(av * 0.2316418882f + 1.0f);
    float q = t * 0.5307027145f + (-0.7265760135f); q = q * t + 0.7107068705f; q = q * t + (-0.142248368f); q = q * t + 0.127414796f; q = q * t;
    const float e = __builtin_amdgcn_exp2f((v * v) * (-0.72134752044f));
    const float m = v * (q * e);
    return v < 0.f ? m : v - m;
}

namespace pg8 {
constexpr int BM = 256, BK = 64, HALF = 128, HTB = HALF * BK * 2, STAGE_BYTES = 8 * HTB, NXCD = 8, WGM = 8;
__host__ __device__ __forceinline__ int lds_byte(int r, int c) { const int st = (r >> 4) * 2 + (c >> 5), rr = r & 15, cc = c & 31, ob = rr * 64 + cc * 2; return st * 1024 + (ob ^ (((ob >> 9) & 1) << 5)); }
__host__ __device__ __forceinline__ void stage_rc(int b, int& R, int& C) { const int st = b / 1024, sb = b % 1024, swz = sb ^ (((sb >> 9) & 1) << 5); R = (st >> 1) * 16 + swz / 64; C = (st & 1) * 32 + (swz % 64) / 2; }
__host__ __device__ __forceinline__ int perm32(int rho) { const int n = rho >> 4, i = rho & 15; return 8 * (i >> 2) + 4 * n + (i & 3); }

struct Unit { int pm, pn; };
__device__ __forceinline__ const char* uni(const char* p) { unsigned lo = __builtin_amdgcn_readfirstlane((unsigned)(size_t)p), hi = __builtin_amdgcn_readfirstlane((unsigned)((size_t)p >> 32));
    asm volatile("s_nop 4" : "+s"(lo), "+s"(hi));
    return (const char*)(((size_t)hi << 32) | (size_t)lo); }
struct Gemm { const bf16_t* A; const bf16_t* Bt; int lda, ldb, M, N, K; int kpn = 1 << 30, koff = 0; };

struct StaticOrder {
    int nM, nN, nwg, G, c;
    __device__ void init(int M_, int N_, int G_, int c_) { nM = M_ / BM; nN = N_ / BM; nwg = nM * nN; G = G_; c = c_; }
    __device__ bool next(int i, Unit& u) const {
        const long Lx = (long)i * G + c; if (Lx >= nwg) return false;
        int wgid = (int)Lx; { const int q = nwg / NXCD, r = nwg % NXCD, xcd = wgid % NXCD, off = wgid / NXCD; wgid = (xcd < r ? xcd * (q + 1) : r * (q + 1) + (xcd - r) * q) + off; }
        const int nig = WGM * nN, gid = wgid / nig, fm = gid * WGM, gsz = (nM - fm) < WGM ? (nM - fm) : WGM;
        u.pm = fm + ((wgid % nig) % gsz); u.pn = (wgid % nig) / gsz; return true;
    }
};

template <class Epi, bool ALIGN_EPI, bool MID = false>
__device__ __forceinline__ void gemm_phase(LAS unsigned char* lds, const Gemm g, const StaticOrder& S, const Epi& E) {
    const int tid = opaque_tid(), wid = __builtin_amdgcn_readfirstlane(tid >> 6), lane = tid & 63, wr = wid >> 2, wc = wid & 3, fr = lane & 15, fq = lane >> 4;
    const int K = g.K, nt = K / BK;
    unsigned voffA, voffB;
    { int R, C; stage_rc(tid * 16, R, C); const int Rb = (R & ~31) + perm32(R & 31);
      voffA = (unsigned)(R * g.lda + C) * 2u; voffB = (unsigned)(Rb * g.ldb + C) * 2u; }
    const size_t kstep = (size_t)(BK * 2);
    const size_t hstepA = (size_t)HALF * g.lda * 2, hstepB = (size_t)HALF * g.ldb * 2;
    const size_t tstepA = 2 * hstepA, tstepB = 2 * hstepB;
    const size_t pstepA = hstepA >> 1, pstepB = hstepB >> 1;
    const unsigned ldsbase = (unsigned)(size_t)lds + (unsigned)wid * 1024u;
    const int aoff = lds_byte(wr * 64 + fr, fq * 8), boff = lds_byte(wc * 32 + fr, fq * 8);
#define PG8_SA(b, h) (((b) * 2 + (h)) * HTB)
#define PG8_SB(b, h) ((4 + (b) * 2 + (h)) * HTB)
#define PG8_STAGE_(bufoff, gbase, voff, pstep) do { const char* _g0 = (const char*)(gbase); const char* _g1 = _g0 + (pstep); const unsigned _l0 = ldsbase + (unsigned)(bufoff), _l1 = _l0 + 8192u; \
        asm volatile("s_mov_b32 m0, %2\n\ts_nop 0\n\tglobal_load_lds_dwordx4 %0, %1" :: "v"(voff), "s"(_g0), "s"(_l0) : "memory"); \
        asm volatile("s_mov_b32 m0, %2\n\ts_nop 0\n\tglobal_load_lds_dwordx4 %0, %1" :: "v"(voff), "s"(_g1), "s"(_l1) : "memory"); } while (0)
#define PG8_STAGE(bufoff, gbase, voff) PG8_STAGE_(bufoff, gbase, voff, (&(voff) == &voffA) ? pstepA : pstepB)
#define PG8_LDA(dst, b, h) do { _Pragma("unroll") for (int m = 0; m < 4; ++m) _Pragma("unroll") for (int k = 0; k < 2; ++k) dst[m][k] = *(const LAS bf16x8*)(lds + PG8_SA(b, h) + aoff + m * 2048 + k * 1024); } while (0)
#define PG8_LDB(dst, b, h) do { _Pragma("unroll") for (int n = 0; n < 2; ++n) _Pragma("unroll") for (int k = 0; k < 2; ++k) dst[n][k] = *(const LAS bf16x8*)(lds + PG8_SB(b, h) + boff + n * 2048 + k * 1024); } while (0)
#define PG8_MMA(ai, bj, At, Bt) do { __builtin_amdgcn_s_setprio(1); _Pragma("unroll") for (int m = 0; m < 4; ++m) _Pragma("unroll") for (int n = 0; n < 2; ++n) _Pragma("unroll") for (int k = 0; k < 2; ++k) \
        acc[ai][bj][m][n] = __builtin_amdgcn_mfma_f32_16x16x32_bf16(Bt[n][k], At[m][k], acc[ai][bj][m][n], 0, 0, 0); __builtin_amdgcn_s_setprio(0); } while (0)
#define PG8_WAIT_V(n) asm volatile("s_waitcnt vmcnt(" #n ")" ::: "memory")
#define PG8_WAIT_L(n) asm volatile("s_waitcnt lgkmcnt(" #n ")" ::: "memory")
#define PG8_BAR __builtin_amdgcn_s_barrier()
#define PG8_SCHED __builtin_amdgcn_sched_barrier(0)
    Unit cur, nxt; int ui = 0;
    if (!S.next(0, cur)) return;
    f32x4 acc[2][2][4][2];
#pragma unroll
    for (int a = 0; a < 2; ++a)
#pragma unroll
        for (int b = 0; b < 2; ++b)
#pragma unroll
            for (int m = 0; m < 4; ++m)
#pragma unroll
                for (int n = 0; n < 2; ++n) acc[a][b][m][n] = (f32x4){0.f, 0.f, 0.f, 0.f};
    bf16x8 At[4][2], B0[2][2], B1[2][2];
    const size_t kob0 = (cur.pn >= g.kpn) ? (size_t)g.koff * 2 : 0;
    const char* cA = uni((const char*)g.A + (size_t)cur.pm * tstepA + kob0); const char* cB = uni((const char*)g.Bt + (size_t)cur.pn * tstepB + kob0);
    PG8_STAGE(PG8_SB(0, 0), cB, voffB); PG8_STAGE(PG8_SB(0, 1), cB + hstepB, voffB); PG8_STAGE(PG8_SA(0, 0), cA, voffA); PG8_STAGE(PG8_SA(0, 1), cA + hstepA, voffA);
    if (wr == 1) PG8_BAR;
    PG8_WAIT_V(2); PG8_BAR;
    PG8_STAGE(PG8_SB(1, 0), cB + kstep, voffB); PG8_STAGE(PG8_SA(1, 0), cA + kstep, voffA); PG8_STAGE(PG8_SB(1, 1), cB + hstepB + kstep, voffB);
    PG8_WAIT_V(6); PG8_BAR;
    for (;;) {
        const bool has_next = S.next(ui + 1, nxt);
        const size_t kob1 = (has_next && nxt.pn >= g.kpn) ? (size_t)g.koff * 2 : 0;
        const char* nA = uni(has_next ? (const char*)g.A + (size_t)nxt.pm * tstepA + kob1 : cA); const char* nB = uni(has_next ? (const char*)g.Bt + (size_t)nxt.pn * tstepB + kob1 : cB);
#pragma unroll 1
        for (int t = 0; t < nt; t += 2) {
            const bool last = (t == nt - 2);
            if constexpr (MID) { if (t == (nt >> 1)) E.mid(acc, cur, wr, wc, fr, fq); }
            const char* a1 = cA + (size_t)(t + 1) * kstep;
            const char* a2 = last ? nA : cA + (size_t)(t + 2) * kstep; const char* b2 = last ? nB : cB + (size_t)(t + 2) * kstep;
            const char* a3 = a2 + kstep; const char* b3 = b2 + kstep;
            PG8_LDB(B0, 0, 0); PG8_LDB(B1, 0, 1); PG8_SCHED; PG8_LDA(At, 0, 0); PG8_STAGE(PG8_SA(1, 1), a1 + hstepA, voffA);
            PG8_WAIT_V(8); PG8_WAIT_L(0); PG8_BAR; PG8_MMA(0, 0, At, B0); PG8_MMA(0, 1, At, B1); PG8_BAR; PG8_SCHED;
            PG8_LDA(At, 0, 1); PG8_STAGE(PG8_SB(0, 0), b2, voffB); PG8_STAGE(PG8_SB(0, 1), b2 + hstepB, voffB); PG8_STAGE(PG8_SA(0, 0), a2, voffA);
            PG8_WAIT_V(8); PG8_WAIT_L(0); PG8_BAR; PG8_MMA(1, 0, At, B0); PG8_MMA(1, 1, At, B1); PG8_BAR; PG8_SCHED;
            PG8_LDB(B0, 1, 0); PG8_LDB(B1, 1, 1); PG8_SCHED; PG8_LDA(At, 1, 0); PG8_STAGE(PG8_SA(0, 1), a2 + hstepA, voffA);
            PG8_WAIT_V(8); PG8_WAIT_L(0); PG8_BAR; PG8_MMA(0, 0, At, B0); PG8_MMA(0, 1, At, B1); PG8_BAR; PG8_SCHED;
            PG8_LDA(At, 1, 1); PG8_STAGE(PG8_SB(1, 0), b3, voffB); PG8_STAGE(PG8_SB(1, 1), b3 + hstepB, voffB); PG8_STAGE(PG8_SA(1, 0), a3, voffA);
            PG8_WAIT_V(8); PG8_WAIT_L(0); PG8_BAR; PG8_MMA(1, 0, At, B0); PG8_MMA(1, 1, At, B1); PG8_BAR; PG8_SCHED;
        }
        if constexpr (ALIGN_EPI) { if (wr == 0) PG8_BAR; }
        E(acc, cur, wr, wc, fr, fq);
        if (!has_next) break;
#pragma unroll
        for (int a = 0; a < 2; ++a)
#pragma unroll
            for (int b = 0; b < 2; ++b)
#pragma unroll
                for (int m = 0; m < 4; ++m)
#pragma unroll
                    for (int n = 0; n < 2; ++n) acc[a][b][m][n] = (f32x4){0.f, 0.f, 0.f, 0.f};
        cur = nxt; cA = nA; cB = nB; ++ui;
        if constexpr (ALIGN_EPI) { if (wr == 1) PG8_BAR; }
    }
    PG8_WAIT_V(0);
    if constexpr (!ALIGN_EPI) { if (wr == 0) PG8_BAR; }
    PG8_BAR;
#undef PG8_SA
#undef PG8_SB
#undef PG8_STAGE
#undef PG8_STAGE_
#undef PG8_LDA
#undef PG8_LDB
#undef PG8_MMA
#undef PG8_WAIT_V
#undef PG8_WAIT_L
#undef PG8_BAR
#undef PG8_SCHED
}

#define EPI_LOOP_BEGIN \
    const int row0 = u.pm * BM + wr * 64 + fr, colb = u.pn * BM + wc * 32 + 8 * fq; \
    _Pragma("unroll") for (int ai = 0; ai < 2; ++ai) _Pragma("unroll") for (int m = 0; m < 4; ++m) { const size_t row = (size_t)(row0 + ai * HALF + m * 16); \
    _Pragma("unroll") for (int bj = 0; bj < 2; ++bj) { const int col = colb + bj * HALF; f32x4 v0 = acc[ai][bj][m][0], v1 = acc[ai][bj][m][1];
#define EPI_LOOP_END } }
#define EPI_SIG typedef const f32x4 (&AccT)[2][2][4][2]; __device__ __forceinline__ void operator()(AccT acc, const Unit& u, int wr, int wc, int fr, int fq) const

__device__ __forceinline__ void st_bf16x8(bf16_t* p, f32x4 v0, f32x4 v1) { u32x4 w; w.x = pk2(v0[0], v0[1]); w.y = pk2(v0[2], v0[3]); w.z = pk2(v1[0], v1[1]); w.w = pk2(v1[2], v1[3]); *(u32x4*)p = w; }
__device__ __forceinline__ void ld_bf16x8(const bf16_t* p, f32x4& v0, f32x4& v1) { const u32x4 w = *(const u32x4*)p; v0 = (f32x4){bflo(w.x), bfhi(w.x), bflo(w.y), bfhi(w.y)}; v1 = (f32x4){bflo(w.z), bfhi(w.z), bflo(w.w), bfhi(w.w)}; }

struct EpiInproj { bf16_t *Prw, *Pgm, *G; EPI_SIG {
    bf16_t* base; int ld, cofs; bool sig = false;
    if (u.pn < 7) { base = Prw; ld = RWC; cofs = 0; } else if (u.pn < 11) { base = Pgm; ld = 1024; cofs = 7 * BM; } else { base = G; ld = 2048; cofs = 11 * BM; sig = true; }
    EPI_LOOP_BEGIN
        if (sig) {
#pragma unroll
            for (int j = 0; j < 4; ++j) { v0[j] = sigmoidf_(v0[j]); v1[j] = sigmoidf_(v1[j]); } }
        st_bf16x8(base + row * ld + (col - cofs), v0, v1);
    EPI_LOOP_END
} };
struct EpiLora { bf16_t* OUT; EPI_SIG {
    const int kind = u.pn >> 1; bf16_t* base = OUT + (size_t)kind * (U / 2) - kind * 512;
    EPI_LOOP_BEGIN
        st_bf16x8(base + row * 512 + col, v0, v1);
    EPI_LOOP_END
} };
struct EpiVres { const bf16_t *V0, *VF; bf16_t* V; int ldv; const float* v0res; EPI_SIG {
    EPI_LOOP_BEGIN
        f32x4 a0, a1, f0, f1; ld_bf16x8(V0 + row * 512 + col, a0, a1); ld_bf16x8(VF + row * 512 + col, f0, f1);
        const f32x4 b0 = *(const f32x4*)(v0res + col), b1 = *(const f32x4*)(v0res + col + 4);
#pragma unroll
        for (int j = 0; j < 4; ++j) { v0[j] = a0[j] + (f0[j] - a0[j]) * sigmoidf_(b0[j] + v0[j]); v1[j] = a1[j] + (f1[j] - a1[j]) * sigmoidf_(b1[j] + v1[j]); }
        st_bf16x8(V + row * ldv + col, v0, v1);
    EPI_LOOP_END
} };
struct EpiMergeF { const bf16_t* G; bf16_t* MG;
    __device__ __forceinline__ void mid(f32x4 (&acc)[2][2][4][2], const Unit& u, int wr, int wc, int fr, int fq) const {
        const int row0 = u.pm * BM + wr * 64 + fr, colb = u.pn * BM + wc * 32 + 8 * fq;
#pragma unroll
        for (int ai = 0; ai < 2; ++ai)
#pragma unroll
            for (int m = 0; m < 4; ++m) { const size_t row = (size_t)(row0 + ai * HALF + m * 16);
#pragma unroll
                for (int bj = 0; bj < 2; ++bj) { const int col = colb + bj * HALF;
                    f32x4 ga0, ga1, gb0, gb1; ld_bf16x8(G + row * 2048 + col, ga0, ga1); ld_bf16x8(G + row * 2048 + 1024 + col, gb0, gb1);
#pragma unroll
                    for (int j = 0; j < 4; ++j) { acc[ai][bj][m][0][j] *= gb0[j] * rcpf_(ga0[j]); acc[ai][bj][m][1][j] *= gb1[j] * rcpf_(ga1[j]); } }
                }
    }
    EPI_SIG {
    EPI_LOOP_BEGIN
        f32x4 g0, g1; ld_bf16x8(G + row * 2048 + col, g0, g1);
        st_bf16x8(MG + row * 1024 + col, g0 * v0, g1 * v1);
    EPI_LOOP_END
} };
struct EpiResid { const float* xin; float* xout; const float* gate; EPI_SIG {
    const float* gb = gate + (size_t)(u.pm >> 4) * NMOD;
    EPI_LOOP_BEGIN
        const f32x4 g0 = *(const f32x4*)(gb + col), g1 = *(const f32x4*)(gb + col + 4);
        const f32x4 x0 = *(const f32x4*)(xin + row * 1024 + col), x1 = *(const f32x4*)(xin + row * 1024 + col + 4);
        *(f32x4*)(xout + row * 1024 + col) = x0 + g0 * v0; *(f32x4*)(xout + row * 1024 + col + 4) = x1 + g1 * v1;
    EPI_LOOP_END
} };
struct EpiFF1 { bf16_t* FH; EPI_SIG {
    EPI_LOOP_BEGIN
#pragma unroll
        for (int j = 0; j < 4; ++j) { float a = fmaxf(v0[j], 0.f), b = fmaxf(v1[j], 0.f); v0[j] = a * a; v1[j] = b * b; }
        st_bf16x8(FH + row * 4096 + col, v0, v1);
    EPI_LOOP_END
} };
}

__device__ __forceinline__ void transpose_item(const float* W, int K, int N, bf16_t* WT, int ldo, LAS float* scr, int item, int lane) {
    const int nblk = N / 32, kb = item / nblk, nb = item % nblk, k0 = 64 * kb, n0 = 32 * nb;
    float tv[32];
#pragma unroll
    for (int i = 0; i < 32; ++i) tv[i] = W[(size_t)(k0 + 2 * i + (lane >> 5)) * N + n0 + (lane & 31)];
#pragma unroll
    for (int i = 0; i < 32; ++i) scr[(2 * i + (lane >> 5)) * 33 + (lane & 31)] = tv[i];
    asm volatile("s_waitcnt lgkmcnt(0)" ::: "memory");
    const int c = lane & 7;
#pragma unroll
    for (int j = 0; j < 4; ++j) { const int n = (lane >> 3) + 8 * j; const LAS float* s = scr + (8 * c) * 33 + n;
        u32x4 o; o.x = f2bf(s[0 * 33]) | (f2bf(s[1 * 33]) << 16); o.y = f2bf(s[2 * 33]) | (f2bf(s[3 * 33]) << 16); o.z = f2bf(s[4 * 33]) | (f2bf(s[5 * 33]) << 16); o.w = f2bf(s[6 * 33]) | (f2bf(s[7 * 33]) << 16);
        *(u32x4*)(WT + (size_t)(n0 + n) * ldo + k0 + 8 * c) = o; }
    asm volatile("s_waitcnt lgkmcnt(0)" ::: "memory");
}

__device__ __forceinline__ void prologue(const Params& p, LAS unsigned char* lds, int tid, int lane, int wave, int bid, int G) {
    bf16_t* Wb = (bf16_t*)p.ws;
    {
        LAS float* scr = (LAS float*)(lds + wave * 16384);
        const int gw = bid * 8 + wave, NGW = G * 8;
        constexpr int I_IN = 16 * 152, I_BR = 8 * 32, I_OUT = 16 * 32, I_FF1 = 16 * 128, I_FF2 = 64 * 32, I_L = I_IN + 2 * I_BR + I_OUT + I_FF1 + I_FF2;
        for (int it = gw; it < NL * I_L; it += NGW) {
            const int l = it / I_L; int r = it % I_L; bf16_t* wl = Wb + (size_t)l * LW;
            if (r < I_IN) { transpose_item(GP(p.w_in) + (size_t)l * 1024 * 4864, 1024, 4864, wl + O_IN, 1024, scr, r, lane); continue; } r -= I_IN;
            if (r < I_BR) { transpose_item(GP(p.w_br_rw) + (size_t)l * 512 * 1024, 512, 1024, wl + O_BR1 + 512, 1024, scr, r, lane); continue; } r -= I_BR;
            if (r < I_BR) { transpose_item(GP(p.w_br_gm) + (size_t)l * 512 * 1024, 512, 1024, wl + O_BR1, 1024, scr, r, lane); continue; } r -= I_BR;
            if (r < I_OUT) { transpose_item(GP(p.w_out) + (size_t)l * 1024 * 1024, 1024, 1024, wl + O_OUT, 1024, scr, r, lane); continue; } r -= I_OUT;
            if (r < I_FF1) { transpose_item(GP(p.w_ff1) + (size_t)l * 1024 * 4096, 1024, 4096, wl + O_FF1, 1024, scr, r, lane); continue; } r -= I_FF1;
            transpose_item(GP(p.w_ff2) + (size_t)l * 4096 * 1024, 4096, 1024, wl + O_FF2, 4096, scr, r, lane);
        }
    }
    {
        const int gt = bid * 512 + tid, NT = G * 512;
        for (int idx = gt; idx < NL * 1536 * 256; idx += NT) {
            const int l = idx / (1536 * 256), r = idx % (1536 * 256), n = r >> 8, k = r & 255; float v = 0.f;
            if (n < 512) { if (k < 64) v = GP(p.w2_decay)[((size_t)l * 64 + k) * 512 + n]; }
            else if (n < 1024) { if (k >= 64 && k < 128) v = GP(p.w2_aaa)[((size_t)l * 64 + (k - 64)) * 512 + (n - 512)]; }
            else { if (k >= 128) v = GP(p.w2_gate)[((size_t)l * 128 + (k - 128)) * 512 + (n - 1024)]; }
            Wb[(size_t)l * LW + O_LORA + r] = (bf16_t)f2bf(v);
        }
        for (int idx = gt; idx < (NL - 1) * 512 * 512; idx += NT) {
            const int l1 = idx / (512 * 512), r = idx % (512 * 512), n = r >> 9, k = r & 511; float s = 0.f;
            const float* w1 = GP(p.w1_res) + ((size_t)l1 * 512 + k) * 32; const float* w2 = GP(p.w2_res) + (size_t)l1 * 32 * 512 + n;
            float w1v[32], w2v[32];
#pragma unroll
            for (int q = 0; q < 32; ++q) { w1v[q] = w1[q]; w2v[q] = w2[(size_t)q * 512]; }
#pragma unroll
            for (int q = 0; q < 32; ++q) s += w1v[q] * w2v[q];
            Wb[(size_t)(l1 + 1) * LW + O_V12 + r] = (bf16_t)f2bf(s);
        }
        for (int idx = gt; idx < NL * 4 * 128 * 128; idx += NT) {
            const int l = idx / 65536, r = idx % 65536, i = (r >> 7) & 127, j = r & 127;
            const float v = ((i >> 6) >= (j >> 6)) ? GP(p.w_sp)[idx] : 0.f;
            Wb[(size_t)l * LW + O_WS + r] = (bf16_t)f2bf(v);
        }
    }
    __syncthreads();
    {
        LAS float* cact = (LAS float*)lds; LAS float* part = (LAS float*)(lds + 65536);
        for (int i = tid; i < NB * DM; i += 512) { const float v = GP(p.c)[i]; cact[i] = v * sigmoidf_(v); }
        __syncthreads();
        float* mod = (float*)(p.ws + WS_MOD);
        const int ks = tid >> 6, nl = tid & 63;
        for (int it = bid; it < NL * 96; it += G) {
            const int l = it / 96, n0 = (it % 96) * 64;
            float a[16];
#pragma unroll
            for (int b = 0; b < 16; ++b) a[b] = 0.f;
            const float* wp = GP(p.w_ada) + ((size_t)l * 1024 + ks * 128) * NMOD + n0 + nl;
            for (int k0 = 0; k0 < 128; k0 += 16) { float w[16];
#pragma unroll
                for (int kk = 0; kk < 16; ++kk) w[kk] = wp[(size_t)(k0 + kk) * NMOD];
#pragma unroll
                for (int kk = 0; kk < 16; ++kk)
#pragma unroll
                    for (int b = 0; b < 16; ++b) a[b] += cact[b * 1024 + ks * 128 + k0 + kk] * w[kk]; }
#pragma unroll
            for (int b = 0; b < 16; ++b) part[(ks * 16 + b) * 64 + nl] = a[b];
            __syncthreads();
#pragma unroll
            for (int e = 0; e < 2; ++e) { const int o = tid + 512 * e, b = o >> 6, n2 = o & 63; float s = GP(p.b_ada)[(size_t)l * NMOD + n0 + n2];
#pragma unroll
                for (int q = 0; q < 8; ++q) s += part[(q * 16 + b) * 64 + n2];
                mod[((size_t)l * NB + b) * NMOD + n0 + n2] = s; }
            __syncthreads();
        }
    }
}

__device__ __forceinline__ void norm_phase(const float* __restrict__ x, const float* __restrict__ gain, const float* __restrict__ modl, int shofs, bf16_t* __restrict__ H, int gw, int NGW, int lane) {
    for (int m0 = gw; m0 < M; m0 += 4 * NGW) {
        f32x4 v[4][4]; float s[4];
#pragma unroll
        for (int r = 0; r < 4; ++r) { const f32x4* xr = (const f32x4*)(x + (size_t)(m0 + r * NGW) * DM) + lane;
#pragma unroll
            for (int j = 0; j < 4; ++j) v[r][j] = xr[64 * j]; }
#pragma unroll
        for (int r = 0; r < 4; ++r) { s[r] = 0.f;
#pragma unroll
            for (int j = 0; j < 4; ++j) s[r] += (v[r][j].x * v[r][j].x + v[r][j].y * v[r][j].y) + (v[r][j].z * v[r][j].z + v[r][j].w * v[r][j].w); }
#pragma unroll
        for (int r = 0; r < 4; ++r) { const int m = m0 + r * NGW;
            const float rstd = rsqrtf(wave_sum(s[r]) * (1.f / DM) + 1e-6f);
            const float* mb = modl + (size_t)(m >> 12) * NMOD + shofs;
            u32x2* o = (u32x2*)(H + (size_t)m * DM) + lane;
#pragma unroll
            for (int j = 0; j < 4; ++j) { const int col = 4 * lane + 256 * j;
                const f32x4 g4 = *(const f32x4*)(gain + col), sh = *(const f32x4*)(mb + col), sc = *(const f32x4*)(mb + 1024 + col);
                const f32x4 h = (v[r][j] * rstd * g4) * (sc + 1.f) + sh;
                u32x2 w; w.x = pk2(h.x, h.y); w.y = pk2(h.z, h.w); o[64 * j] = w; } }
    }
}
__device__ __forceinline__ void final_norm(float* x, const float* __restrict__ gain, int gw, int NGW, int lane) {
    for (int m0 = gw; m0 < M; m0 += 4 * NGW) {
        f32x4 v[4][4]; float s[4];
#pragma unroll
        for (int r = 0; r < 4; ++r) { const f32x4* xr = (const f32x4*)(x + (size_t)(m0 + r * NGW) * DM) + lane;
#pragma unroll
            for (int j = 0; j < 4; ++j) v[r][j] = xr[64 * j]; }
#pragma unroll
        for (int r = 0; r < 4; ++r) { s[r] = 0.f;
#pragma unroll
            for (int j = 0; j < 4; ++j) s[r] += (v[r][j].x * v[r][j].x + v[r][j].y * v[r][j].y) + (v[r][j].z * v[r][j].z + v[r][j].w * v[r][j].w); }
#pragma unroll
        for (int r = 0; r < 4; ++r) { f32x4* xr = (f32x4*)(x + (size_t)(m0 + r * NGW) * DM) + lane;
            const float rstd = rsqrtf(wave_sum(s[r]) * (1.f / DM) + 1e-6f);
#pragma unroll
            for (int j = 0; j < 4; ++j) { const f32x4 g4 = *(const f32x4*)(gain + 4 * lane + 256 * j); xr[64 * j] = v[r][j] * rstd * g4; } }
    }
}

__device__ __forceinline__ void prep1_phase(const bf16_t* __restrict__ Prw, const float* __restrict__ mu, bf16_t* __restrict__ R, bf16_t* __restrict__ K0, bf16_t* __restrict__ V0, bf16_t* __restrict__ LIN, int gt, int NT) {
    constexpr int CH = RWC / 8;
    for (int idx0 = gt; idx0 < M * CH; idx0 += 8 * NT) {
        u32x4 cw[8], pw[8]; f32x4 m0[8], m1[8];
#pragma unroll
        for (int u = 0; u < 8; ++u) { const int idx = idx0 + u * NT, m = idx / CH, col = (idx % CH) * 8;
            cw[u] = *(const u32x4*)(Prw + (size_t)m * RWC + col);
            pw[u] = ((m & (SEQ - 1)) != 0) ? *(const u32x4*)(Prw + (size_t)(m - 1) * RWC + col) : (u32x4){0u, 0u, 0u, 0u};
            m0[u] = *(const f32x4*)(mu + col); m1[u] = *(const f32x4*)(mu + col + 4); }
#pragma unroll
        for (int u = 0; u < 8; ++u) { const int idx = idx0 + u * NT, m = idx / CH, col = (idx % CH) * 8;
            const f32x4 c0 = (f32x4){bflo(cw[u].x), bfhi(cw[u].x), bflo(cw[u].y), bfhi(cw[u].y)}, c1 = (f32x4){bflo(cw[u].z), bfhi(cw[u].z), bflo(cw[u].w), bfhi(cw[u].w)};
            const f32x4 p0 = (f32x4){bflo(pw[u].x), bfhi(pw[u].x), bflo(pw[u].y), bfhi(pw[u].y)}, p1 = (f32x4){bflo(pw[u].z), bfhi(pw[u].z), bflo(pw[u].w), bfhi(pw[u].w)};
            f32x4 x0 = c0 + (p0 - c0) * m0[u], x1 = c1 + (p1 - c1) * m1[u];
            bf16_t* dst;
            if (col < 512) dst = R + (size_t)m * 512 + col;
            else if (col < 1024) dst = K0 + (size_t)m * 512 + (col - 512);
            else if (col < 1536) dst = V0 + (size_t)m * 512 + (col - 1024);
            else { dst = LIN + (size_t)m * 256 + (col - 1536);
                if (col < 1600) {
#pragma unroll
                    for (int j = 0; j < 4; ++j) { x0[j] = tanhf_(x0[j]); x1[j] = tanhf_(x1[j]); } }
                else if (col >= 1664) {
#pragma unroll
                    for (int j = 0; j < 4; ++j) { x0[j] = sigmoidf_(x0[j]); x1[j] = sigmoidf_(x1[j]); } } }
            pg8::st_bf16x8(dst, x0, x1); }
    }
}

__device__ __forceinline__ void gmlp_item(LAS unsigned char* lds, bf16_t* Pgm, bf16_t* Yo, const bf16_t* __restrict__ Wsm, const float* __restrict__ lnw, const float* __restrict__ lnb, const float* __restrict__ bsp, int item, int tid, int lane, int wave) {
    LAS float* stats = (LAS float*)lds;
    LAS bf16_t* Vs = (LAS bf16_t*)(lds + 1024);
    constexpr int VP = 130;
    const size_t m0 = (size_t)item * 128;
#pragma unroll
    for (int hb = 0; hb < 2; ++hb) {
        u32x4 raw[8];
#pragma unroll
        for (int e = 0; e < 8; ++e) raw[e] = *(const u32x4*)(Pgm + (m0 + wave * 16 + hb * 8 + e) * 1024 + 512 + lane * 8);
#pragma unroll
        for (int e = 0; e < 8; ++e) { const int tk = wave * 16 + hb * 8 + e; float s = 0.f, ss = 0.f;
            const unsigned w4[4] = {raw[e].x, raw[e].y, raw[e].z, raw[e].w};
#pragma unroll
            for (int j = 0; j < 4; ++j) { const float g0 = gelu1(bflo(w4[j])), g1 = gelu1(bfhi(w4[j])); s += g0 + g1; ss += g0 * g0 + g1 * g1; }
            s = wave_sum(s); ss = wave_sum(ss);
            const float mean = s * (1.f / 512.f), var = fmaxf(ss * (1.f / 512.f) - mean * mean, 0.f);
            if (lane == 0) { stats[tk * 2] = mean; stats[tk * 2 + 1] = rsqrtf(var + 1e-5f); } }
    }
    __syncthreads();
    const int fr = lane & 15, fq = lane >> 4;
    const int i = 16 * wave + fr;
    const int nkc = (wave < 4) ? 2 : 4;
#pragma unroll 1
    for (int g = 0; g < 4; ++g) {
        u32x4 vraw[4]; bf16x8 af[4]; u32x2 uw[8];
#pragma unroll
        for (int it = 0; it < 4; ++it) { const int q = tid + 512 * it, j = q >> 4, dc = q & 15; vraw[it] = *(const u32x4*)(Pgm + (m0 + j) * 1024 + 512 + g * 128 + dc * 8); }
#pragma unroll
        for (int kc = 0; kc < 4; ++kc) if (kc < nkc) af[kc] = *(const bf16x8*)(Wsm + ((size_t)g * 128 + i) * 128 + kc * 32 + fq * 8);
        bf16_t* urow = Pgm + (m0 + i) * 1024 + g * 128 + fq * 4;
#pragma unroll
        for (int dt = 0; dt < 8; ++dt) uw[dt] = *(const u32x2*)(urow + dt * 16);
        const float bs = bsp[g * 128 + i];
#pragma unroll
        for (int it = 0; it < 4; ++it) { const int q = tid + 512 * it, j = q >> 4, dc = q & 15;
            const float mean = stats[j * 2], rstd = stats[j * 2 + 1];
            const f32x4 w0 = *(const f32x4*)(lnw + g * 128 + dc * 8), w1 = *(const f32x4*)(lnw + g * 128 + dc * 8 + 4);
            const f32x4 b0 = *(const f32x4*)(lnb + g * 128 + dc * 8), b1 = *(const f32x4*)(lnb + g * 128 + dc * 8 + 4);
            f32x4 a0 = (f32x4){bflo(vraw[it].x), bfhi(vraw[it].x), bflo(vraw[it].y), bfhi(vraw[it].y)}, a1 = (f32x4){bflo(vraw[it].z), bfhi(vraw[it].z), bflo(vraw[it].w), bfhi(vraw[it].w)};
#pragma unroll
            for (int e = 0; e < 4; ++e) { a0[e] = (gelu1(a0[e]) - mean) * rstd * w0[e] + b0[e]; a1[e] = (gelu1(a1[e]) - mean) * rstd * w1[e] + b1[e]; }
            LAS unsigned* dst = (LAS unsigned*)(Vs + j * VP + dc * 8);
            dst[0] = pk2(a0[0], a0[1]); dst[1] = pk2(a0[2], a0[3]); dst[2] = pk2(a1[0], a1[1]); dst[3] = pk2(a1[2], a1[3]); }
        __syncthreads();
        f32x4 acc[8];
#pragma unroll
        for (int dt = 0; dt < 8; ++dt) { acc[dt] = (f32x4){0.f, 0.f, 0.f, 0.f};
#pragma unroll
            for (int kc = 0; kc < 4; ++kc) if (kc < nkc) { bf16x8 bfv;
#pragma unroll
                for (int e = 0; e < 8; ++e) bfv[e] = (short)Vs[(kc * 32 + fq * 8 + e) * VP + dt * 16 + fr];
                acc[dt] = __builtin_amdgcn_mfma_f32_16x16x32_bf16(bfv, af[kc], acc[dt], 0, 0, 0); } }
#pragma unroll
        for (int dt = 0; dt < 8; ++dt) {
            const float y0 = gelu1(bflo(uw[dt].x)) * (acc[dt][0] + bs), y1 = gelu1(bfhi(uw[dt].x)) * (acc[dt][1] + bs), y2 = gelu1(bflo(uw[dt].y)) * (acc[dt][2] + bs), y3 = gelu1(bfhi(uw[dt].y)) * (acc[dt][3] + bs);
            u32x2 o; o.x = pk2(y0, y1); o.y = pk2(y2, y3); *(u32x2*)(Yo + (m0 + i) * 1024 + g * 128 + fq * 4 + dt * 16) = o; }
        __syncthreads();
    }
}

__device__ __forceinline__ void scan_phase(LAS unsigned char* lds, const bf16_t* __restrict__ R, const bf16_t* __restrict__ K0, const bf16_t* __restrict__ AS, const bf16_t* __restrict__ OMD, const bf16_t* __restrict__ V, int ldv,
                                           bf16_t* __restrict__ Y, float* __restrict__ CB, const float* k_k, const float* k_a, const float* r_k, const float* w0p, const float* a0p, int bid, int tid) {
    constexpr int CT = 32, VF32 = CT * 64, BUFF = 6 * VF32;
    LAS float* buf = (LAS float*)lds;
    LAS float* ybuf = (LAS float*)(lds + 2 * BUFF * 4);
    const int bh = bid >> 1, half = bid & 1, b = bh >> 3, h = bh & 7;
    const int lane = tid & 63, wave = __builtin_amdgcn_readfirstlane(tid >> 6);
    const size_t mrow0 = (size_t)b * SEQ;
    constexpr int NCH = SEQ / CT;
    if (wave >= 4) {
        const int lt = tid - 256, tt = lt >> 4, jg = lt & 15, jl = 4 * jg, colL = h * 64 + jl;
        const f32x4 kk4 = *(const f32x4*)(k_k + colL), ka4 = *(const f32x4*)(k_a + colL), rk4 = *(const f32x4*)(r_k + colL), wz4 = *(const f32x4*)(w0p + colL), az4 = *(const f32x4*)(a0p + colL);
        u32x2 Pr0, Pk0, Pa0, Po0, Pv0, Pr1, Pk1, Pa1, Po1, Pv1;
#define SCAN_LOAD1(c, tk, Pr, Pk, Pa, Po, Pv) do { const size_t m_ = mrow0 + (size_t)(c) * CT + (tk); \
        Pr = *(const u32x2*)(R + m_ * 512 + colL); Pk = *(const u32x2*)(K0 + m_ * 512 + colL); Pa = *(const u32x2*)(AS + m_ * 512 + colL); \
        Po = *(const u32x2*)(OMD + m_ * 512 + colL); Pv = *(const u32x2*)(V + m_ * (size_t)ldv + colL); } while (0)
#define SCAN_LOAD(c) do { SCAN_LOAD1(c, tt, Pr0, Pk0, Pa0, Po0, Pv0); SCAN_LOAD1(c, tt + 16, Pr1, Pk1, Pa1, Po1, Pv1); } while (0)
#define SCAN_FILL1(c, nb, tk, Pr, Pk, Pa, Po, Pv) do { LAS float* B_ = buf + (nb) * BUFF + (tk) * 64 + jl; \
        const f32x4 r4 = (f32x4){bflo(Pr.x), bfhi(Pr.x), bflo(Pr.y), bfhi(Pr.y)}, k4 = (f32x4){bflo(Pk.x), bfhi(Pk.x), bflo(Pk.y), bfhi(Pk.y)}; \
        const f32x4 al = (f32x4){bflo(Pa.x), bfhi(Pa.x), bflo(Pa.y), bfhi(Pa.y)}, ol = (f32x4){bflo(Po.x), bfhi(Po.x), bflo(Po.y), bfhi(Po.y)}; \
        f32x4 a4, w4; _Pragma("unroll") for (int e_ = 0; e_ < 4; ++e_) { a4[e_] = sigmoidf_(az4[e_] + al[e_]); w4[e_] = decay_of(wz4[e_] + ol[e_]); } \
        const f32x4 q4 = k4 * kk4; const float ssq = row_sum16((q4.x * q4.x + q4.y * q4.y) + (q4.z * q4.z + q4.w * q4.w)); const float inv = 1.f / fmaxf(sqrtf(ssq), 1e-12f); \
        const f32x4 n4 = q4 * inv; const f32x4 km4 = k4 * ((a4 - 1.f) * ka4 + 1.f); const f32x4 bo4 = r4 * km4 * rk4; \
        const float bon = row_sum16((bo4.x + bo4.y) + (bo4.z + bo4.w)); \
        *(LAS f32x4*)(B_ + 0 * VF32) = w4; *(LAS f32x4*)(B_ + 1 * VF32) = -n4; *(LAS f32x4*)(B_ + 2 * VF32) = n4 * a4; *(LAS f32x4*)(B_ + 3 * VF32) = km4; *(LAS f32x4*)(B_ + 4 * VF32) = r4; \
        *(LAS f32x4*)(B_ + 5 * VF32) = (f32x4){bflo(Pv.x), bfhi(Pv.x), bflo(Pv.y), bfhi(Pv.y)}; \
        if (half == 0 && jg == 0) CB[(mrow0 + (size_t)(c) * CT + (tk)) * 8 + h] = bon; } while (0)
#define SCAN_FILL(c, nb) do { SCAN_FILL1(c, nb, tt, Pr0, Pk0, Pa0, Po0, Pv0); SCAN_FILL1(c, nb, tt + 16, Pr1, Pk1, Pa1, Po1, Pv1); } while (0)
#define SCAN_WRITE(c, yb_) do { const int t2_ = lt >> 3, ip_ = lt & 7; const size_t m_ = mrow0 + (size_t)(c) * CT + t2_; \
        const f32x4 yy_ = *(const LAS f32x4*)((yb_) + t2_ * 32 + 4 * ip_); u32x2 o_; o_.x = pk2(yy_.x, yy_.y); o_.y = pk2(yy_.z, yy_.w); *(u32x2*)(Y + m_ * 512 + h * 64 + half * 32 + 4 * ip_) = o_; } while (0)
        SCAN_LOAD(0); SCAN_FILL(0, 0); SCAN_LOAD(1);
        __syncthreads();
#pragma unroll 1
        for (int c = 0; c < NCH; ++c) {
            const int cur = c & 1;
            if (c > 0) SCAN_WRITE(c - 1, ybuf + (cur ^ 1) * (CT * 32));
            if (c + 1 < NCH) { SCAN_FILL(c + 1, cur ^ 1); if (c + 2 < NCH) SCAN_LOAD(c + 2); }
            __syncthreads();
        }
        SCAN_WRITE(NCH - 1, ybuf + ((NCH - 1) & 1) * (CT * 32));
#undef SCAN_LOAD1
#undef SCAN_LOAD
#undef SCAN_FILL1
#undef SCAN_FILL
#undef SCAN_WRITE
    } else {
        const int rloc = wave * 8 + (lane >> 3), irow = half * 32 + rloc, jq = lane & 7, j0 = jq * 8;
        f32x2 s0 = (f32x2){0.f, 0.f}, s1 = s0, s2 = s0, s3 = s0;
        const unsigned lds0 = (unsigned)(size_t)buf;
        __syncthreads();
#define DSR128(dst, addr, off) asm volatile("ds_read_b128 %0, %1 offset:%2" : "=v"(dst) : "v"(addr), "n"(off))
#define DSR32(dst, addr, off) asm volatile("ds_read_b32 %0, %1 offset:%2" : "=v"(dst) : "v"(addr), "n"(off))
#define SC_PART1(PE) const f32x2 pa = (s0 * (f32x2){PE##A0.x, PE##A0.y} + s1 * (f32x2){PE##A0.z, PE##A0.w}) + (s2 * (f32x2){PE##A1.x, PE##A1.y} + s3 * (f32x2){PE##A1.z, PE##A1.w}); \
                const f32x2 v2 = (f32x2){PE##v, PE##v}; \
                const f32x2 t0 = s0 * (f32x2){PE##W0.x, PE##W0.y} + v2 * (f32x2){PE##K0.x, PE##K0.y}, t1 = s1 * (f32x2){PE##W0.z, PE##W0.w} + v2 * (f32x2){PE##K0.z, PE##K0.w}; \
                const f32x2 t2 = s2 * (f32x2){PE##W1.x, PE##W1.y} + v2 * (f32x2){PE##K1.x, PE##K1.y}, t3 = s3 * (f32x2){PE##W1.z, PE##W1.w} + v2 * (f32x2){PE##K1.z, PE##K1.w}; \
                const float sa = red8(pa.x + pa.y); const f32x2 sa2 = (f32x2){sa, sa};
#define SC_PART2(PL, tq_, yk_) s0 = t0 + sa2 * (f32x2){PL##B0.x, PL##B0.y}; s1 = t1 + sa2 * (f32x2){PL##B0.z, PL##B0.w}; s2 = t2 + sa2 * (f32x2){PL##B1.x, PL##B1.y}; s3 = t3 + sa2 * (f32x2){PL##B1.z, PL##B1.w}; \
                { const f32x2 py = (s0 * (f32x2){PL##R0.x, PL##R0.y} + s1 * (f32x2){PL##R0.z, PL##R0.w}) + (s2 * (f32x2){PL##R1.x, PL##R1.y} + s3 * (f32x2){PL##R1.z, PL##R1.w}); \
                  const float y = red8(py.x + py.y); yk_ = (jq == (tq_)) ? y : yk_; }
#pragma unroll 1
        for (int c = 0; c < NCH; ++c) {
            const int cur = c & 1;
            LAS float* yb = ybuf + cur * (CT * 32);
            float yk0 = 0.f, yk1 = 0.f, yk2 = 0.f, yk3 = 0.f;
            const unsigned qa = lds0 + (unsigned)(cur * BUFF + j0) * 4u, va = lds0 + (unsigned)(cur * BUFF + 5 * VF32 + irow) * 4u;
            f32x4 EAA0, EAA1, EAW0, EAW1, EAK0, EAK1, EBA0, EBA1, EBW0, EBW1, EBK0, EBK1, ECA0, ECA1, ECW0, ECW1, ECK0, ECK1, LAB0, LAB1, LAR0, LAR1, LBB0, LBB1, LBR0, LBR1; float EAv, EBv, ECv;
            DSR128(EAA0, qa, 8192); DSR128(EAA1, qa, 8208); DSR128(EAW0, qa, 0); DSR128(EAW1, qa, 16); DSR128(EAK0, qa, 24576); DSR128(EAK1, qa, 24592); DSR32(EAv, va, 0); DSR128(LAB0, qa, 16384); DSR128(LAB1, qa, 16400); DSR128(LAR0, qa, 32768); DSR128(LAR1, qa, 32784); DSR128(EBA0, qa, 8448); DSR128(EBA1, qa, 8464); DSR128(EBW0, qa, 256); DSR128(EBW1, qa, 272); DSR128(EBK0, qa, 24832); DSR128(EBK1, qa, 24848); DSR32(EBv, va, 256);
            { asm volatile("s_waitcnt lgkmcnt(11)" : "+v"(EAA0), "+v"(EAA1), "+v"(EAW0), "+v"(EAW1), "+v"(EAK0), "+v"(EAK1), "+v"(EAv)); DSR128(LBB0, qa, 16640); DSR128(LBB1, qa, 16656); DSR128(LBR0, qa, 33024); DSR128(LBR1, qa, 33040); DSR128(ECA0, qa, 8704); DSR128(ECA1, qa, 8720); DSR128(ECW0, qa, 512); DSR128(ECW1, qa, 528); DSR128(ECK0, qa, 25088); DSR128(ECK1, qa, 25104); DSR32(ECv, va, 512); SC_PART1(EA) asm volatile("s_waitcnt lgkmcnt(15)" : "+v"(LAB0), "+v"(LAB1), "+v"(LAR0), "+v"(LAR1)); SC_PART2(LA, 0, yk0) }
            { asm volatile("s_waitcnt lgkmcnt(11)" : "+v"(EBA0), "+v"(EBA1), "+v"(EBW0), "+v"(EBW1), "+v"(EBK0), "+v"(EBK1), "+v"(EBv)); DSR128(LAB0, qa, 16896); DSR128(LAB1, qa, 16912); DSR128(LAR0, qa, 33280); DSR128(LAR1, qa, 33296); DSR128(EAA0, qa, 8960); DSR128(EAA1, qa, 8976); DSR128(EAW0, qa, 768); DSR128(EAW1, qa, 784); DSR128(EAK0, qa, 25344); DSR128(EAK1, qa, 25360); DSR32(EAv, va, 768); SC_PART1(EB) asm volatile("s_waitcnt lgkmcnt(15)" : "+v"(LBB0), "+v"(LBB1), "+v"(LBR0), "+v"(LBR1)); SC_PART2(LB, 1, yk0) }
            { asm volatile("s_waitcnt lgkmcnt(11)" : "+v"(ECA0), "+v"(ECA1), "+v"(ECW0), "+v"(ECW1), "+v"(ECK0), "+v"(ECK1), "+v"(ECv)); DSR128(LBB0, qa, 17152); DSR128(LBB1, qa, 17168); DSR128(LBR0, qa, 33536); DSR128(LBR1, qa, 33552); DSR128(EBA0, qa, 9216); DSR128(EBA1, qa, 9232); DSR128(EBW0, qa, 1024); DSR128(EBW1, qa, 1040); DSR128(EBK0, qa, 25600); DSR128(EBK1, qa, 25616); DSR32(EBv, va, 1024); SC_PART1(EC) asm volatile("s_waitcnt lgkmcnt(15)" : "+v"(LAB0), "+v"(LAB1), "+v"(LAR0), "+v"(LAR1)); SC_PART2(LA, 2, yk0) }
            { asm volatile("s_waitcnt lgkmcnt(11)" : "+v"(EAA0), "+v"(EAA1), "+v"(EAW0), "+v"(EAW1), "+v"(EAK0), "+v"(EAK1), "+v"(EAv)); DSR128(LAB0, qa, 17408); DSR128(LAB1, qa, 17424); DSR128(LAR0, qa, 33792); DSR128(LAR1, qa, 33808); DSR128(ECA0, qa, 9472); DSR128(ECA1, qa, 9488); DSR128(ECW0, qa, 1280); DSR128(ECW1, qa, 1296); DSR128(ECK0, qa, 25856); DSR128(ECK1, qa, 25872); DSR32(ECv, va, 1280); SC_PART1(EA) asm volatile("s_waitcnt lgkmcnt(15)" : "+v"(LBB0), "+v"(LBB1), "+v"(LBR0), "+v"(LBR1)); SC_PART2(LB, 3, yk0) }
            { asm volatile("s_waitcnt lgkmcnt(11)" : "+v"(EBA0), "+v"(EBA1), "+v"(EBW0), "+v"(EBW1), "+v"(EBK0), "+v"(EBK1), "+v"(EBv)); DSR128(LBB0, qa, 17664); DSR128(LBB1, qa, 17680); DSR128(LBR0, qa, 34048); DSR128(LBR1, qa, 34064); DSR128(EAA0, qa, 9728); DSR128(EAA1, qa, 9744); DSR128(EAW0, qa, 1536); DSR128(EAW1, qa, 1552); DSR128(EAK0, qa, 26112); DSR128(EAK1, qa, 26128); DSR32(EAv, va, 1536); SC_PART1(EB) asm volatile("s_waitcnt lgkmcnt(15)" : "+v"(LAB0), "+v"(LAB1), "+v"(LAR0), "+v"(LAR1)); SC_PART2(LA, 4, yk0) }
            { asm volatile("s_waitcnt lgkmcnt(11)" : "+v"(ECA0), "+v"(ECA1), "+v"(ECW0), "+v"(ECW1), "+v"(ECK0), "+v"(ECK1), "+v"(ECv)); DSR128(LAB0, qa, 17920); DSR128(LAB1, qa, 17936); DSR128(LAR0, qa, 34304); DSR128(LAR1, qa, 34320); DSR128(EBA0, qa, 9984); DSR128(EBA1, qa, 10000); DSR128(EBW0, qa, 1792); DSR128(EBW1, qa, 1808); DSR128(EBK0, qa, 26368); DSR128(EBK1, qa, 26384); DSR32(EBv, va, 1792); SC_PART1(EC) asm volatile("s_waitcnt lgkmcnt(15)" : "+v"(LBB0), "+v"(LBB1), "+v"(LBR0), "+v"(LBR1)); SC_PART2(LB, 5, yk0) }
            { asm volatile("s_waitcnt lgkmcnt(11)" : "+v"(EAA0), "+v"(EAA1), "+v"(EAW0), "+v"(EAW1), "+v"(EAK0), "+v"(EAK1), "+v"(EAv)); DSR128(LBB0, qa, 18176); DSR128(LBB1, qa, 18192); DSR128(LBR0, qa, 34560); DSR128(LBR1, qa, 34576); DSR128(ECA0, qa, 10240); DSR128(ECA1, qa, 10256); DSR128(ECW0, qa, 2048); DSR128(ECW1, qa, 2064); DSR128(ECK0, qa, 26624); DSR128(ECK1, qa, 26640); DSR32(ECv, va, 2048); SC_PART1(EA) asm volatile("s_waitcnt lgkmcnt(15)" : "+v"(LAB0), "+v"(LAB1), "+v"(LAR0), "+v"(LAR1)); SC_PART2(LA, 6, yk0) }
            { asm volatile("s_waitcnt lgkmcnt(11)" : "+v"(EBA0), "+v"(EBA1), "+v"(EBW0), "+v"(EBW1), "+v"(EBK0), "+v"(EBK1), "+v"(EBv)); DSR128(LAB0, qa, 18432); DSR128(LAB1, qa, 18448); DSR128(LAR0, qa, 34816); DSR128(LAR1, qa, 34832); DSR128(EAA0, qa, 10496); DSR128(EAA1, qa, 10512); DSR128(EAW0, qa, 2304); DSR128(EAW1, qa, 2320); DSR128(EAK0, qa, 26880); DSR128(EAK1, qa, 26896); DSR32(EAv, va, 2304); SC_PART1(EB) asm volatile("s_waitcnt lgkmcnt(15)" : "+v"(LBB0), "+v"(LBB1), "+v"(LBR0), "+v"(LBR1)); SC_PART2(LB, 7, yk0) }
            { asm volatile("s_waitcnt lgkmcnt(11)" : "+v"(ECA0), "+v"(ECA1), "+v"(ECW0), "+v"(ECW1), "+v"(ECK0), "+v"(ECK1), "+v"(ECv)); DSR128(LBB0, qa, 18688); DSR128(LBB1, qa, 18704); DSR128(LBR0, qa, 35072); DSR128(LBR1, qa, 35088); DSR128(EBA0, qa, 10752); DSR128(EBA1, qa, 10768); DSR128(EBW0, qa, 2560); DSR128(EBW1, qa, 2576); DSR128(EBK0, qa, 27136); DSR128(EBK1, qa, 27152); DSR32(EBv, va, 2560); SC_PART1(EC) asm volatile("s_waitcnt lgkmcnt(15)" : "+v"(LAB0), "+v"(LAB1), "+v"(LAR0), "+v"(LAR1)); SC_PART2(LA, 0, yk1) }
            { asm volatile("s_waitcnt lgkmcnt(11)" : "+v"(EAA0), "+v"(EAA1), "+v"(EAW0), "+v"(EAW1), "+v"(EAK0), "+v"(EAK1), "+v"(EAv)); DSR128(LAB0, qa, 18944); DSR128(LAB1, qa, 18960); DSR128(LAR0, qa, 35328); DSR128(LAR1, qa, 35344); DSR128(ECA0, qa, 11008); DSR128(ECA1, qa, 11024); DSR128(ECW0, qa, 2816); DSR128(ECW1, qa, 2832); DSR128(ECK0, qa, 27392); DSR128(ECK1, qa, 27408); DSR32(ECv, va, 2816); SC_PART1(EA) asm volatile("s_waitcnt lgkmcnt(15)" : "+v"(LBB0), "+v"(LBB1), "+v"(LBR0), "+v"(LBR1)); SC_PART2(LB, 1, yk1) }
            { asm volatile("s_waitcnt lgkmcnt(11)" : "+v"(EBA0), "+v"(EBA1), "+v"(EBW0), "+v"(EBW1), "+v"(EBK0), "+v"(EBK1), "+v"(EBv)); DSR128(LBB0, qa, 19200); DSR128(LBB1, qa, 19216); DSR128(LBR0, qa, 35584); DSR128(LBR1, qa, 35600); DSR128(EAA0, qa, 11264); DSR128(EAA1, qa, 11280); DSR128(EAW0, qa, 3072); DSR128(EAW1, qa, 3088); DSR128(EAK0, qa, 27648); DSR128(EAK1, qa, 27664); DSR32(EAv, va, 3072); SC_PART1(EB) asm volatile("s_waitcnt lgkmcnt(15)" : "+v"(LAB0), "+v"(LAB1), "+v"(LAR0), "+v"(LAR1)); SC_PART2(LA, 2, yk1) }
            { asm volatile("s_waitcnt lgkmcnt(11)" : "+v"(ECA0), "+v"(ECA1), "+v"(ECW0), "+v"(ECW1), "+v"(ECK0), "+v"(ECK1), "+v"(ECv)); DSR128(LAB0, qa, 19456); DSR128(LAB1, qa, 19472); DSR128(LAR0, qa, 35840); DSR128(LAR1, qa, 35856); DSR128(EBA0, qa, 11520); DSR128(EBA1, qa, 11536); DSR128(EBW0, qa, 3328); DSR128(EBW1, qa, 3344); DSR128(EBK0, qa, 27904); DSR128(EBK1, qa, 27920); DSR32(EBv, va, 3328); SC_PART1(EC) asm volatile("s_waitcnt lgkmcnt(15)" : "+v"(LBB0), "+v"(LBB1), "+v"(LBR0), "+v"(LBR1)); SC_PART2(LB, 3, yk1) }
            { asm volatile("s_waitcnt lgkmcnt(11)" : "+v"(EAA0), "+v"(EAA1), "+v"(EAW0), "+v"(EAW1), "+v"(EAK0), "+v"(EAK1), "+v"(EAv)); DSR128(LBB0, qa, 19712); DSR128(LBB1, qa, 19728); DSR128(LBR0, qa, 36096); DSR128(LBR1, qa, 36112); DSR128(ECA0, qa, 11776); DSR128(ECA1, qa, 11792); DSR128(ECW0, qa, 3584); DSR128(ECW1, qa, 3600); DSR128(ECK0, qa, 28160); DSR128(ECK1, qa, 28176); DSR32(ECv, va, 3584); SC_PART1(EA) asm volatile("s_waitcnt lgkmcnt(15)" : "+v"(LAB0), "+v"(LAB1), "+v"(LAR0), "+v"(LAR1)); SC_PART2(LA, 4, yk1) }
            { asm volatile("s_waitcnt lgkmcnt(11)" : "+v"(EBA0), "+v"(EBA1), "+v"(EBW0), "+v"(EBW1), "+v"(EBK0), "+v"(EBK1), "+v"(EBv)); DSR128(LAB0, qa, 19968); DSR128(LAB1, qa, 19984); DSR128(LAR0, qa, 36352); DSR128(LAR1, qa, 36368); DSR128(EAA0, qa, 12032); DSR128(EAA1, qa, 12048); DSR128(EAW0, qa, 3840); DSR128(EAW1, qa, 3856); DSR128(EAK0, qa, 28416); DSR128(EAK1, qa, 28432); DSR32(EAv, va, 3840); SC_PART1(EB) asm volatile("s_waitcnt lgkmcnt(15)" : "+v"(LBB0), "+v"(LBB1), "+v"(LBR0), "+v"(LBR1)); SC_PART2(LB, 5, yk1) }
            { asm volatile("s_waitcnt lgkmcnt(11)" : "+v"(ECA0), "+v"(ECA1), "+v"(ECW0), "+v"(ECW1), "+v"(ECK0), "+v"(ECK1), "+v"(ECv)); DSR128(LBB0, qa, 20224); DSR128(LBB1, qa, 20240); DSR128(LBR0, qa, 36608); DSR128(LBR1, qa, 36624); DSR128(EBA0, qa, 12288); DSR128(EBA1, qa, 12304); DSR128(EBW0, qa, 4096); DSR128(EBW1, qa, 4112); DSR128(EBK0, qa, 28672); DSR128(EBK1, qa, 28688); DSR32(EBv, va, 4096); SC_PART1(EC) asm volatile("s_waitcnt lgkmcnt(15)" : "+v"(LAB0), "+v"(LAB1), "+v"(LAR0), "+v"(LAR1)); SC_PART2(LA, 6, yk1) }
            { asm volatile("s_waitcnt lgkmcnt(11)" : "+v"(EAA0), "+v"(EAA1), "+v"(EAW0), "+v"(EAW1), "+v"(EAK0), "+v"(EAK1), "+v"(EAv)); DSR128(LAB0, qa, 20480); DSR128(LAB1, qa, 20496); DSR128(LAR0, qa, 36864); DSR128(LAR1, qa, 36880); DSR128(ECA0, qa, 12544); DSR128(ECA1, qa, 12560); DSR128(ECW0, qa, 4352); DSR128(ECW1, qa, 4368); DSR128(ECK0, qa, 28928); DSR128(ECK1, qa, 28944); DSR32(ECv, va, 4352); SC_PART1(EA) asm volatile("s_waitcnt lgkmcnt(15)" : "+v"(LBB0), "+v"(LBB1), "+v"(LBR0), "+v"(LBR1)); SC_PART2(LB, 7, yk1) }
            { asm volatile("s_waitcnt lgkmcnt(11)" : "+v"(EBA0), "+v"(EBA1), "+v"(EBW0), "+v"(EBW1), "+v"(EBK0), "+v"(EBK1), "+v"(EBv)); DSR128(LBB0, qa, 20736); DSR128(LBB1, qa, 20752); DSR128(LBR0, qa, 37120); DSR128(LBR1, qa, 37136); DSR128(EAA0, qa, 12800); DSR128(EAA1, qa, 12816); DSR128(EAW0, qa, 4608); DSR128(EAW1, qa, 4624); DSR128(EAK0, qa, 29184); DSR128(EAK1, qa, 29200); DSR32(EAv, va, 4608); SC_PART1(EB) asm volatile("s_waitcnt lgkmcnt(15)" : "+v"(LAB0), "+v"(LAB1), "+v"(LAR0), "+v"(LAR1)); SC_PART2(LA, 0, yk2) }
            { asm volatile("s_waitcnt lgkmcnt(11)" : "+v"(ECA0), "+v"(ECA1), "+v"(ECW0), "+v"(ECW1), "+v"(ECK0), "+v"(ECK1), "+v"(ECv)); DSR128(LAB0, qa, 20992); DSR128(LAB1, qa, 21008); DSR128(LAR0, qa, 37376); DSR128(LAR1, qa, 37392); DSR128(EBA0, qa, 13056); DSR128(EBA1, qa, 13072); DSR128(EBW0, qa, 4864); DSR128(EBW1, qa, 4880); DSR128(EBK0, qa, 29440); DSR128(EBK1, qa, 29456); DSR32(EBv, va, 4864); SC_PART1(EC) asm volatile("s_waitcnt lgkmcnt(15)" : "+v"(LBB0), "+v"(LBB1), "+v"(LBR0), "+v"(LBR1)); SC_PART2(LB, 1, yk2) }
            { asm volatile("s_waitcnt lgkmcnt(11)" : "+v"(EAA0), "+v"(EAA1), "+v"(EAW0), "+v"(EAW1), "+v"(EAK0), "+v"(EAK1), "+v"(EAv)); DSR128(LBB0, qa, 21248); DSR128(LBB1, qa, 21264); DSR128(LBR0, qa, 37632); DSR128(LBR1, qa, 37648); DSR128(ECA0, qa, 13312); DSR128(ECA1, qa, 13328); DSR128(ECW0, qa, 5120); DSR128(ECW1, qa, 5136); DSR128(ECK0, qa, 29696); DSR128(ECK1, qa, 29712); DSR32(ECv, va, 5120); SC_PART1(EA) asm volatile("s_waitcnt lgkmcnt(15)" : "+v"(LAB0), "+v"(LAB1), "+v"(LAR0), "+v"(LAR1)); SC_PART2(LA, 2, yk2) }
            { asm volatile("s_waitcnt lgkmcnt(11)" : "+v"(EBA0), "+v"(EBA1), "+v"(EBW0), "+v"(EBW1), "+v"(EBK0), "+v"(EBK1), "+v"(EBv)); DSR128(LAB0, qa, 21504); DSR128(LAB1, qa, 21520); DSR128(LAR0, qa, 37888); DSR128(LAR1, qa, 37904); DSR128(EAA0, qa, 13568); DSR128(EAA1, qa, 13584); DSR128(EAW0, qa, 5376); DSR128(EAW1, qa, 5392); DSR128(EAK0, qa, 29952); DSR128(EAK1, qa, 29968); DSR32(EAv, va, 5376); SC_PART1(EB) asm volatile("s_waitcnt lgkmcnt(15)" : "+v"(LBB0), "+v"(LBB1), "+v"(LBR0), "+v"(LBR1)); SC_PART2(LB, 3, yk2) }
            { asm volatile("s_waitcnt lgkmcnt(11)" : "+v"(ECA0), "+v"(ECA1), "+v"(ECW0), "+v"(ECW1), "+v"(ECK0), "+v"(ECK1), "+v"(ECv)); DSR128(LBB0, qa, 21760); DSR128(LBB1, qa, 21776); DSR128(LBR0, qa, 38144); DSR128(LBR1, qa, 38160); DSR128(EBA0, qa, 13824); DSR128(EBA1, qa, 13840); DSR128(EBW0, qa, 5632); DSR128(EBW1, qa, 5648); DSR128(EBK0, qa, 30208); DSR128(EBK1, qa, 30224); DSR32(EBv, va, 5632); SC_PART1(EC) asm volatile("s_waitcnt lgkmcnt(15)" : "+v"(LAB0), "+v"(LAB1), "+v"(LAR0), "+v"(LAR1)); SC_PART2(LA, 4, yk2) }
            { asm volatile("s_waitcnt lgkmcnt(11)" : "+v"(EAA0), "+v"(EAA1), "+v"(EAW0), "+v"(EAW1), "+v"(EAK0), "+v"(EAK1), "+v"(EAv)); DSR128(LAB0, qa, 22016); DSR128(LAB1, qa, 22032); DSR128(LAR0, qa, 38400); DSR128(LAR1, qa, 38416); DSR128(ECA0, qa, 14080); DSR128(ECA1, qa, 14096); DSR128(ECW0, qa, 5888); DSR128(ECW1, qa, 5904); DSR128(ECK0, qa, 30464); DSR128(ECK1, qa, 30480); DSR32(ECv, va, 5888); SC_PART1(EA) asm volatile("s_waitcnt lgkmcnt(15)" : "+v"(LBB0), "+v"(LBB1), "+v"(LBR0), "+v"(LBR1)); SC_PART2(LB, 5, yk2) }
            { asm volatile("s_waitcnt lgkmcnt(11)" : "+v"(EBA0), "+v"(EBA1), "+v"(EBW0), "+v"(EBW1), "+v"(EBK0), "+v"(EBK1), "+v"(EBv)); DSR128(LBB0, qa, 22272); DSR128(LBB1, qa, 22288); DSR128(LBR0, qa, 38656); DSR128(LBR1, qa, 38672); DSR128(EAA0, qa, 14336); DSR128(EAA1, qa, 14352); DSR128(EAW0, qa, 6144); DSR128(EAW1, qa, 6160); DSR128(EAK0, qa, 30720); DSR128(EAK1, qa, 30736); DSR32(EAv, va, 6144); SC_PART1(EB) asm volatile("s_waitcnt lgkmcnt(15)" : "+v"(LAB0), "+v"(LAB1), "+v"(LAR0), "+v"(LAR1)); SC_PART2(LA, 6, yk2) }
            { asm volatile("s_waitcnt lgkmcnt(11)" : "+v"(ECA0), "+v"(ECA1), "+v"(ECW0), "+v"(ECW1), "+v"(ECK0), "+v"(ECK1), "+v"(ECv)); DSR128(LAB0, qa, 22528); DSR128(LAB1, qa, 22544); DSR128(LAR0, qa, 38912); DSR128(LAR1, qa, 38928); DSR128(EBA0, qa, 14592); DSR128(EBA1, qa, 14608); DSR128(EBW0, qa, 6400); DSR128(EBW1, qa, 6416); DSR128(EBK0, qa, 30976); DSR128(EBK1, qa, 30992); DSR32(EBv, va, 6400); SC_PART1(EC) asm volatile("s_waitcnt lgkmcnt(15)" : "+v"(LBB0), "+v"(LBB1), "+v"(LBR0), "+v"(LBR1)); SC_PART2(LB, 7, yk2) }
            { asm volatile("s_waitcnt lgkmcnt(11)" : "+v"(EAA0), "+v"(EAA1), "+v"(EAW0), "+v"(EAW1), "+v"(EAK0), "+v"(EAK1), "+v"(EAv)); DSR128(LBB0, qa, 22784); DSR128(LBB1, qa, 22800); DSR128(LBR0, qa, 39168); DSR128(LBR1, qa, 39184); DSR128(ECA0, qa, 14848); DSR128(ECA1, qa, 14864); DSR128(ECW0, qa, 6656); DSR128(ECW1, qa, 6672); DSR128(ECK0, qa, 31232); DSR128(ECK1, qa, 31248); DSR32(ECv, va, 6656); SC_PART1(EA) asm volatile("s_waitcnt lgkmcnt(15)" : "+v"(LAB0), "+v"(LAB1), "+v"(LAR0), "+v"(LAR1)); SC_PART2(LA, 0, yk3) }
            { asm volatile("s_waitcnt lgkmcnt(11)" : "+v"(EBA0), "+v"(EBA1), "+v"(EBW0), "+v"(EBW1), "+v"(EBK0), "+v"(EBK1), "+v"(EBv)); DSR128(LAB0, qa, 23040); DSR128(LAB1, qa, 23056); DSR128(LAR0, qa, 39424); DSR128(LAR1, qa, 39440); DSR128(EAA0, qa, 15104); DSR128(EAA1, qa, 15120); DSR128(EAW0, qa, 6912); DSR128(EAW1, qa, 6928); DSR128(EAK0, qa, 31488); DSR128(EAK1, qa, 31504); DSR32(EAv, va, 6912); SC_PART1(EB) asm volatile("s_waitcnt lgkmcnt(15)" : "+v"(LBB0), "+v"(LBB1), "+v"(LBR0), "+v"(LBR1)); SC_PART2(LB, 1, yk3) }
            { asm volatile("s_waitcnt lgkmcnt(11)" : "+v"(ECA0), "+v"(ECA1), "+v"(ECW0), "+v"(ECW1), "+v"(ECK0), "+v"(ECK1), "+v"(ECv)); DSR128(LBB0, qa, 23296); DSR128(LBB1, qa, 23312); DSR128(LBR0, qa, 39680); DSR128(LBR1, qa, 39696); DSR128(EBA0, qa, 15360); DSR128(EBA1, qa, 15376); DSR128(EBW0, qa, 7168); DSR128(EBW1, qa, 7184); DSR128(EBK0, qa, 31744); DSR128(EBK1, qa, 31760); DSR32(EBv, va, 7168); SC_PART1(EC) asm volatile("s_waitcnt lgkmcnt(15)" : "+v"(LAB0), "+v"(LAB1), "+v"(LAR0), "+v"(LAR1)); SC_PART2(LA, 2, yk3) }
            { asm volatile("s_waitcnt lgkmcnt(11)" : "+v"(EAA0), "+v"(EAA1), "+v"(EAW0), "+v"(EAW1), "+v"(EAK0), "+v"(EAK1), "+v"(EAv)); DSR128(LAB0, qa, 23552); DSR128(LAB1, qa, 23568); DSR128(LAR0, qa, 39936); DSR128(LAR1, qa, 39952); DSR128(ECA0, qa, 15616); DSR128(ECA1, qa, 15632); DSR128(ECW0, qa, 7424); DSR128(ECW1, qa, 7440); DSR128(ECK0, qa, 32000); DSR128(ECK1, qa, 32016); DSR32(ECv, va, 7424); SC_PART1(EA) asm volatile("s_waitcnt lgkmcnt(15)" : "+v"(LBB0), "+v"(LBB1), "+v"(LBR0), "+v"(LBR1)); SC_PART2(LB, 3, yk3) }
            { asm volatile("s_waitcnt lgkmcnt(11)" : "+v"(EBA0), "+v"(EBA1), "+v"(EBW0), "+v"(EBW1), "+v"(EBK0), "+v"(EBK1), "+v"(EBv)); DSR128(LBB0, qa, 23808); DSR128(LBB1, qa, 23824); DSR128(LBR0, qa, 40192); DSR128(LBR1, qa, 40208); DSR128(EAA0, qa, 15872); DSR128(EAA1, qa, 15888); DSR128(EAW0, qa, 7680); DSR128(EAW1, qa, 7696); DSR128(EAK0, qa, 32256); DSR128(EAK1, qa, 32272); DSR32(EAv, va, 7680); SC_PART1(EB) asm volatile("s_waitcnt lgkmcnt(15)" : "+v"(LAB0), "+v"(LAB1), "+v"(LAR0), "+v"(LAR1)); SC_PART2(LA, 4, yk3) }
            { asm volatile("s_waitcnt lgkmcnt(11)" : "+v"(ECA0), "+v"(ECA1), "+v"(ECW0), "+v"(ECW1), "+v"(ECK0), "+v"(ECK1), "+v"(ECv)); DSR128(LAB0, qa, 24064); DSR128(LAB1, qa, 24080); DSR128(LAR0, qa, 40448); DSR128(LAR1, qa, 40464); DSR128(EBA0, qa, 16128); DSR128(EBA1, qa, 16144); DSR128(EBW0, qa, 7936); DSR128(EBW1, qa, 7952); DSR128(EBK0, qa, 32512); DSR128(EBK1, qa, 32528); DSR32(EBv, va, 7936); SC_PART1(EC) asm volatile("s_waitcnt lgkmcnt(15)" : "+v"(LBB0), "+v"(LBB1), "+v"(LBR0), "+v"(LBR1)); SC_PART2(LB, 5, yk3) }
            { asm volatile("s_waitcnt lgkmcnt(11)" : "+v"(EAA0), "+v"(EAA1), "+v"(EAW0), "+v"(EAW1), "+v"(EAK0), "+v"(EAK1), "+v"(EAv)); DSR128(LBB0, qa, 24320); DSR128(LBB1, qa, 24336); DSR128(LBR0, qa, 40704); DSR128(LBR1, qa, 40720); SC_PART1(EA) asm volatile("s_waitcnt lgkmcnt(11)" : "+v"(LAB0), "+v"(LAB1), "+v"(LAR0), "+v"(LAR1)); SC_PART2(LA, 6, yk3) }
            { asm volatile("s_waitcnt lgkmcnt(4)" : "+v"(EBA0), "+v"(EBA1), "+v"(EBW0), "+v"(EBW1), "+v"(EBK0), "+v"(EBK1), "+v"(EBv)); SC_PART1(EB) asm volatile("s_waitcnt lgkmcnt(0)" : "+v"(LBB0), "+v"(LBB1), "+v"(LBR0), "+v"(LBR1)); SC_PART2(LB, 7, yk3) }
            yb[jq * 32 + rloc] = yk0; yb[(jq + 8) * 32 + rloc] = yk1; yb[(jq + 16) * 32 + rloc] = yk2; yb[(jq + 24) * 32 + rloc] = yk3;
            __syncthreads();
        }
#undef DSR128
#undef DSR32
#undef SC_PART1
#undef SC_PART2
    }
}
__device__ __forceinline__ void post_phase(bf16_t* Y, bf16_t* Yo, const bf16_t* __restrict__ V, int ldv, const bf16_t* __restrict__ GT, const float* __restrict__ CB, const float* gn_w, const float* gn_b, int ghw, int NHW, int tid) {
    const int jp = tid & 31, h = ghw & 7, col = h * 64 + 2 * jp;
    const float gw0 = gn_w[col], gw1 = gn_w[col + 1], gb0 = gn_b[col], gb1 = gn_b[col + 1];
    for (int g0 = ghw; g0 < M * 8; g0 += 8 * NHW) {
        unsigned yw[8], vw[8], gg[8]; float bon[8];
#pragma unroll
        for (int u = 0; u < 8; ++u) { const int g = g0 + u * NHW; const size_t m = (size_t)(g >> 3);
            yw[u] = *(const unsigned*)(Y + m * 512 + col); vw[u] = *(const unsigned*)(V + m * (size_t)ldv + col); gg[u] = *(const unsigned*)(GT + m * 512 + col); bon[u] = CB[g]; }
#pragma unroll
        for (int u = 0; u < 8; ++u) { const int g = g0 + u * NHW; const size_t m = (size_t)(g >> 3);
            const float y0 = bflo(yw[u]), y1 = bfhi(yw[u]);
            const float mean = half_sum(y0 + y1) * (1.f / 64.f);
            const float d0 = y0 - mean, d1 = y1 - mean;
            const float var = half_sum(d0 * d0 + d1 * d1) * (1.f / 64.f);
            const float rs = rsqrtf(var + 64e-5f);
            const float o0 = (d0 * rs * gw0 + gb0 + bon[u] * bflo(vw[u])) * bflo(gg[u]), o1 = (d1 * rs * gw1 + gb1 + bon[u] * bfhi(vw[u])) * bfhi(gg[u]);
            *(unsigned*)(Yo + m * 1024 + col) = pk2(o0, o1); }
    }
}

#define XB_TMO      128
#define XB_XCNT(j)  (256  + 64 * (j))
#define XB_XSUB(j)  (1280 + 64 * (j))
#define XB_XGEN(j)  (2304 + 64 * (j))
#define XB_TOP      3328
#define XB_TOPGEN   3392
#define XCD_BAR_WORDS 3456
#define XB_SPIN_CAP (1u << 18)

__device__ __forceinline__ unsigned xb_ld(unsigned* p)              { return __hip_atomic_load(p, __ATOMIC_RELAXED, __HIP_MEMORY_SCOPE_AGENT); }
__device__ __forceinline__ unsigned xb_add(unsigned* p, unsigned v) { return __hip_atomic_fetch_add(p, v, __ATOMIC_RELAXED, __HIP_MEMORY_SCOPE_AGENT); }
__device__ __forceinline__ unsigned xb_xcc_id() { return (unsigned)__builtin_amdgcn_s_getreg((3 << 11) | 20) & 0xFu; }
#define XB_SPIN(cond, bar) do { unsigned _sp = 0; while (cond) { __builtin_amdgcn_s_sleep(1); \
    if ((++_sp & 255u) == 0u) { if (xb_ld(&(bar)[XB_TMO])) break; if (_sp > XB_SPIN_CAP) { atomicAdd(&(bar)[XB_TMO], 1u); break; } } } } while (0)

struct XcdBarrier {
    unsigned* bar; unsigned x;
    volatile LAS unsigned* st;
};

__device__ __forceinline__ XcdBarrier xcd_barrier_post(unsigned* bar, volatile LAS unsigned* st) {
    XcdBarrier b; b.bar = bar; b.x = xb_xcc_id(); b.st = st;
    if (threadIdx.x == 0) (void)xb_add(&bar[XB_XCNT(b.x)], 1u);
    return b;
}
__device__ __forceinline__ void xcd_barrier_complete(unsigned* bar, unsigned x, unsigned& nloc, unsigned& nx) {
    const unsigned G = gridDim.x * gridDim.y * gridDim.z;
    unsigned sum, cnt, mine, sp = 0u;
    for (;;) {
        sum = 0u; cnt = 0u; mine = 0u;
#pragma unroll
        for (unsigned j = 0; j < 16; ++j) { const unsigned c = xb_ld(&bar[XB_XCNT(j)]); sum += c; cnt += (c > 0u) ? 1u : 0u; mine = (j == x) ? c : mine; }
        if (sum == G) break;
        __builtin_amdgcn_s_sleep(1);
        if ((++sp & 255u) == 0u) { if (xb_ld(&bar[XB_TMO])) break; if (sp > XB_SPIN_CAP) { atomicAdd(&bar[XB_TMO], 1u); break; } }
    }
    nloc = mine > 0u ? mine : 1u; nx = cnt > 0u ? cnt : 1u;
}

__device__ __forceinline__ void xcd_barrier(const XcdBarrier& b) {
    asm volatile("s_waitcnt vmcnt(0)" ::: "memory");
    __syncthreads();
    if (threadIdx.x == 0) {
        unsigned* bar = b.bar;
        __builtin_amdgcn_s_waitcnt(0);
        unsigned nloc = b.st[0], nx = b.st[1];
        if (nloc == 0u) { xcd_barrier_complete(bar, b.x, nloc, nx); b.st[0] = nloc; b.st[1] = nx; }
        const unsigned old = xb_add(&bar[XB_XSUB(b.x)], 1u);
        const unsigned gen = old / nloc;
        if (old + 1u == (gen + 1u) * nloc) {
            __builtin_amdgcn_fence(__ATOMIC_RELEASE, "agent");
            asm volatile("s_waitcnt vmcnt(0)" ::: "memory");
            const unsigned og = xb_add(&bar[XB_TOP], 1u);
            const unsigned tg = og / nx;
            if (og + 1u == (tg + 1u) * nx) xb_add(&bar[XB_TOPGEN], 1u);
            else XB_SPIN(xb_ld(&bar[XB_TOPGEN]) == tg, bar);
            __builtin_amdgcn_fence(__ATOMIC_ACQUIRE, "agent");
            xb_add(&bar[XB_XGEN(b.x)], 1u);
            asm volatile("s_waitcnt vmcnt(0)" ::: "memory");
        } else {
            XB_SPIN(xb_ld(&bar[XB_XGEN(b.x)]) == gen, bar);
            __builtin_amdgcn_fence(__ATOMIC_ACQUIRE, "agent");
            asm volatile("s_waitcnt vmcnt(0)" ::: "memory");
        }
    }
    __syncthreads();
}


#ifndef PHM
#define PHM 0xFFFF
#endif
#define PH(k) ((PHM >> (k)) & 1)
#ifndef DUPM
#define DUPM 0
#endif
#define DUP(k) ((DUPM >> (k)) & 1)
#define REP(k) for (int rep_ = 0; rep_ < PH(k) + DUP(k); ++rep_)
#define WSP(T, off) ((T*)(T GAS*)(q->ws + (off)))
__global__ void __launch_bounds__(512, 2) mega_fwd(Params p_unused) {
    extern __shared__ __attribute__((aligned(16))) unsigned char lds_raw[];
    LAS unsigned char* lds = (LAS unsigned char*)lds_raw;
    cg::grid_group grid = cg::this_grid();
    const int G = gridDim.x, NGW = G * 8, NT = G * 512;
    volatile LAS unsigned* bst = (volatile LAS unsigned*)(lds + 131072);
    if (threadIdx.x < 2) bst[threadIdx.x] = 0u;
    __syncthreads();
    const XcdBarrier xbar = xcd_barrier_post((unsigned*)(((const Params*)__builtin_amdgcn_kernarg_segment_ptr())->ws + WS_BAR), bst);
#define GSYNC() xcd_barrier(xbar)

    REP(0) { const Params* q = opaque_params(); const int t_ = opaque_tid(); prologue(*q, lds, t_, t_ & 63, __builtin_amdgcn_readfirstlane(t_ >> 6), opaque_bid(), G); }
    grid.sync();

#pragma unroll 1
    for (int l = 0; l < NL; ++l) {
        REP(1) { const Params* q = opaque_params(); const int t_ = opaque_tid();
            norm_phase(l == 0 ? GP(q->x) : ((float*)(q->out)), GP(q->norm1_g) + l * DM, WSP(const float, WS_MOD) + (size_t)l * NB * NMOD, 0, WSP(bf16_t, WS_H), opaque_bid() * 8 + (t_ >> 6), NGW, t_ & 63); }
        GSYNC();
        REP(2) { const Params* q = opaque_params(); const bf16_t* Wl = WSP(const bf16_t, 0) + (size_t)l * LW;
            pg8::Gemm g{WSP(bf16_t, WS_H), Wl + O_IN, DM, DM, M, INC, DM}; pg8::StaticOrder S; S.init(M, INC, G, opaque_bid());
            pg8::EpiInproj E{WSP(bf16_t, WS_PRW), WSP(bf16_t, WS_PGM), WSP(bf16_t, WS_G)};
            pg8::gemm_phase<pg8::EpiInproj, true>(lds, g, S, E); }
        GSYNC();
        if (PH(3)) { const Params* q = opaque_params(); const int t_ = opaque_tid(); const bf16_t* Wl = WSP(const bf16_t, 0) + (size_t)l * LW;
            for (int it = opaque_bid(); it < M / 128; it += G)
                gmlp_item(lds, WSP(bf16_t, WS_PGM), WSP(bf16_t, WS_PGM), Wl + O_WS, GP(q->ln_w) + l * 512, GP(q->ln_b) + l * 512, GP(q->b_sp) + l * 512, it, t_, t_ & 63, __builtin_amdgcn_readfirstlane(t_ >> 6)); }
        REP(4) { const Params* q = opaque_params();
            prep1_phase(WSP(bf16_t, WS_PRW), GP(q->mu_shift) + l * RWC, WSP(bf16_t, WS_R), WSP(bf16_t, WS_K0), l == 0 ? WSP(bf16_t, WS_VF) : WSP(bf16_t, WS_V0), WSP(bf16_t, WS_LIN), opaque_bid() * 512 + opaque_tid(), NT); }
        GSYNC();
        REP(5) { const Params* q = opaque_params(); const bf16_t* Wl = WSP(const bf16_t, 0) + (size_t)l * LW;
            pg8::Gemm g{WSP(bf16_t, WS_LIN), Wl + O_LORA, 256, 256, M, 1536, 128, 4, 128};    pg8::StaticOrder S; S.init(M, 1536, G, opaque_bid());
            pg8::EpiLora E{WSP(bf16_t, WS_OMD)};
            pg8::gemm_phase<pg8::EpiLora, true>(lds, g, S, E); }
        if (l > 0) REP(6) { const Params* q = opaque_params(); const bf16_t* Wl = WSP(const bf16_t, 0) + (size_t)l * LW;
            pg8::Gemm g{WSP(bf16_t, WS_V0), Wl + O_V12, 512, 512, M, 512, 512}; pg8::StaticOrder S; S.init(M, 512, G, opaque_bid());
            pg8::EpiVres E{WSP(bf16_t, WS_V0), WSP(bf16_t, WS_VF), WSP(bf16_t, WS_PGM) + 512, 1024, GP(q->v0_res) + (l - 1) * 512};
            pg8::gemm_phase<pg8::EpiVres, true>(lds, g, S, E); }
        GSYNC();
        REP(7) { const Params* q = opaque_params();
            scan_phase(lds, WSP(bf16_t, WS_R), WSP(bf16_t, WS_K0), WSP(bf16_t, WS_ASIG), WSP(bf16_t, WS_OMD), l == 0 ? WSP(bf16_t, WS_VF) : WSP(bf16_t, WS_PGM) + 512, l == 0 ? 512 : 1024,
                       WSP(bf16_t, WS_YRW), WSP(float, WS_CB), GP(q->k_k) + l * 512, GP(q->k_a) + l * 512, GP(q->r_k) + l * 512, GP(q->w0_decay) + l * 512, GP(q->a0) + l * 512, opaque_bid(), opaque_tid()); }
        GSYNC();
        REP(13) { const Params* q = opaque_params(); const int t_ = opaque_tid();
            post_phase(WSP(bf16_t, WS_YRW), WSP(bf16_t, WS_PGM) + 512, l == 0 ? WSP(bf16_t, WS_VF) : WSP(bf16_t, WS_PGM) + 512, l == 0 ? 512 : 1024, WSP(bf16_t, WS_GT), WSP(const float, WS_CB),
                       GP(q->gn_w) + l * 512, GP(q->gn_b) + l * 512, opaque_bid() * 16 + (t_ >> 5), G * 16, t_); }
        GSYNC();
        REP(8) { const Params* q = opaque_params(); const bf16_t* Wl = WSP(const bf16_t, 0) + (size_t)l * LW;
            pg8::StaticOrder S; S.init(M, DM, G, opaque_bid());
            pg8::Gemm g1{WSP(bf16_t, WS_PGM), Wl + O_BR1, 1024, 1024, M, DM, 1024}; pg8::EpiMergeF E1{WSP(bf16_t, WS_G), WSP(bf16_t, WS_MG)};
            pg8::gemm_phase<pg8::EpiMergeF, true, true>(lds, g1, S, E1); }
        GSYNC();
        REP(9) { const Params* q = opaque_params(); const bf16_t* Wl = WSP(const bf16_t, 0) + (size_t)l * LW;
            pg8::Gemm g{WSP(bf16_t, WS_MG), Wl + O_OUT, DM, DM, M, DM, DM}; pg8::StaticOrder S; S.init(M, DM, G, opaque_bid());
            pg8::EpiResid E{l == 0 ? GP(q->x) : ((float*)(q->out)), ((float*)(q->out)), WSP(const float, WS_MOD) + (size_t)l * NB * NMOD + 2 * DM};
            pg8::gemm_phase<pg8::EpiResid, true>(lds, g, S, E); }
        GSYNC();
        REP(10) { const Params* q = opaque_params(); const int t_ = opaque_tid();
            norm_phase(((float*)(q->out)), GP(q->norm2_g) + l * DM, WSP(const float, WS_MOD) + (size_t)l * NB * NMOD, 3 * DM, WSP(bf16_t, WS_H), opaque_bid() * 8 + (t_ >> 6), NGW, t_ & 63); }
        GSYNC();
        REP(11) { const Params* q = opaque_params(); const bf16_t* Wl = WSP(const bf16_t, 0) + (size_t)l * LW;
            pg8::Gemm g{WSP(bf16_t, WS_H), Wl + O_FF1, DM, DM, M, DFF, DM}; pg8::StaticOrder S; S.init(M, DFF, G, opaque_bid());
            pg8::EpiFF1 E{WSP(bf16_t, WS_FH)};
            pg8::gemm_phase<pg8::EpiFF1, true>(lds, g, S, E); }
        GSYNC();
        REP(12) { const Params* q = opaque_params(); const bf16_t* Wl = WSP(const bf16_t, 0) + (size_t)l * LW;
            pg8::Gemm g{WSP(bf16_t, WS_FH), Wl + O_FF2, DFF, DFF, M, DM, DFF}; pg8::StaticOrder S; S.init(M, DM, G, opaque_bid());
            pg8::EpiResid E{((float*)(q->out)), ((float*)(q->out)), WSP(const float, WS_MOD) + (size_t)l * NB * NMOD + 5 * DM};
            pg8::gemm_phase<pg8::EpiResid, true>(lds, g, S, E); }
        GSYNC();
    }
    { const Params* q = opaque_params(); const int t_ = opaque_tid(); final_norm(((float*)(q->out)), GP(q->final_g), opaque_bid() * 8 + (t_ >> 6), NGW, t_ & 63); }
}

extern "C" void kernel_launch(void* const* d_in, const int* in_sizes, int n_in, void* d_out, int out_size, void* d_ws, size_t ws_size, hipStream_t stream) {
    static int grid = 0;
    if (grid == 0) {
        if (n_in != 31 || ws_size < WS_END) { fprintf(stderr, "kernel_launch: unexpected n_in %d / ws_size %zu\n", n_in, ws_size); grid = -1; return; }
        int dev = 0, cus = 0, per_cu = 0;
        hipGetDevice(&dev);
        hipDeviceGetAttribute(&cus, hipDeviceAttributeMultiprocessorCount, dev);
        hipFuncSetAttribute((const void*)mega_fwd, hipFuncAttributeMaxDynamicSharedMemorySize, LDS_BYTES);
        hipOccupancyMaxActiveBlocksPerMultiprocessor(&per_cu, (const void*)mega_fwd, 512, LDS_BYTES);
        if (per_cu < 1) { fprintf(stderr, "kernel_launch: occupancy query says %d blocks/CU\n", per_cu); per_cu = 1; }
        if (cus != 256) { fprintf(stderr, "kernel_launch: built for 256 CUs, found %d\n", cus); grid = -1; return; }
        grid = cus;
        (void)hipGetLastError();
    }
    if (grid < 0) return;
    Params p{};
    const float** pp = (const float**)&p;
    for (int i = 0; i < 31; ++i) pp[i] = (const float*)d_in[i];
    p.out = (float GAS*)d_out; p.ws = (unsigned char GAS*)d_ws;
    if (hipMemsetAsync((char*)d_ws + WS_BAR, 0, WS_BAR_BYTES, stream) != hipSuccess) { fprintf(stderr, "kernel_launch: memset of the barrier words failed\n"); return; }
    void* args[] = {&p};
    hipError_t e = hipLaunchCooperativeKernel((const void*)mega_fwd, dim3(grid), dim3(512), args, LDS_BYTES, stream);
    if (e != hipSuccess) fprintf(stderr, "cooperative launch failed: %s (grid %d)\n", hipGetErrorString(e), grid);
}
```
